# Optimizing an MI355X kernel written in HIP

```python
import math
import jax, jax.numpy as jnp
from jax import lax
import numpy as np

D_MODEL = 1024
BATCH = 8
SEQ = 2048
DEPTH = 1
DEC_BATCH = 32
DEC_SEQ = 8
PAST_LEN = 16384
PAGE_SIZE = 128

HEAD_DIM = 64
D_MIX = D_MODEL
D_A = D_MIX // 2
A_GROUPS = D_A // HEAD_DIM
CHUNK = 128
N_HEADS = (D_MIX - D_A) // HEAD_DIM
D_B = N_HEADS * HEAD_DIM
N_KV = 2
GQA = N_HEADS // N_KV
KV_COLS = N_KV * HEAD_DIM
CMP_BLOCK = 32
CMP_STRIDE = 16
CMP_RATIO = CMP_BLOCK // CMP_STRIDE
CMP_HIDDEN = 128
SLC_BLOCK = 64
TOP_N = 16
WINDOW = 512
ROPE_THETA = 10000.0
EPS = 1e-6
Q_BLOCK = 64
WIN_QBLOCK = 128
SCALE = HEAD_DIM ** -0.5
NEG = -1e30
FORCE = 1e9
D_IN = 3 * D_A + D_B + 6 * KV_COLS + 3 * N_HEADS + D_B

kernel_name = 'hymba_gmlp_nsa_decode_step'


def rmsnorm(x, g):
    xf = x.astype(jnp.float32)
    y = xf * lax.rsqrt(jnp.mean(xf * xf, axis=-1, keepdims=True) + EPS)
    return y.astype(x.dtype) * g


def layernorm(x, g, b):
    xf = x.astype(jnp.float32)
    mu = jnp.mean(xf, axis=-1, keepdims=True)
    var = jnp.mean(jnp.square(xf - mu), axis=-1, keepdims=True)
    return ((xf - mu) * lax.rsqrt(var + EPS)).astype(x.dtype) * g + b


def rope(x, pos):
    half = HEAD_DIM // 2
    inv = ROPE_THETA ** (-jnp.arange(half, dtype=jnp.float32) / half)
    ang = pos.astype(jnp.float32)[:, None] * inv
    shape = (pos.shape[0],) + (1,) * (x.ndim - 3) + (half,)
    cos = jnp.cos(ang).reshape(shape)
    sin = jnp.sin(ang).reshape(shape)
    xf = x.astype(jnp.float32)
    x1, x2 = xf[..., :half], xf[..., half:]
    return jnp.concatenate([x1 * cos - x2 * sin, x2 * cos + x1 * sin], axis=-1).astype(x.dtype)


def masked_softmax(s, mask):
    s = jnp.where(mask, s.astype(jnp.float32), NEG)
    e = jnp.where(mask, jnp.exp(s - jnp.max(s, axis=-1, keepdims=True)), 0.0)
    return e / jnp.maximum(jnp.sum(e, axis=-1, keepdims=True), 1.0)


def project(x, norm_g, w_in):
    B, T, _ = x.shape
    p = rmsnorm(x, norm_g) @ w_in
    cuts = np.cumsum([D_A, D_A, D_A, D_B, 6 * KV_COLS, 3 * N_HEADS]).tolist()
    u, v, z_a, q, kv, g, z_b = jnp.split(p, cuts, axis=-1)
    return (jax.nn.gelu(u), jax.nn.gelu(v), z_a,
            q.reshape(B, T, N_KV, GQA, HEAD_DIM),
            kv.reshape(B, T, 6, N_KV, HEAD_DIM),
            jax.nn.sigmoid(g.reshape(B, T, N_KV, GQA, 3)), z_b)


def chunk_gmlp(u, v, ln_g, ln_b, w_s, b_s):
    B, T, _ = v.shape
    v = layernorm(v, ln_g, ln_b)
    n_c = -(-T // CHUNK)
    vp = jnp.pad(v, ((0, 0), (0, n_c * CHUNK - T), (0, 0))).reshape(B, n_c, CHUNK, A_GROUPS, HEAD_DIM)
    w = w_s * jnp.tril(jnp.ones((CHUNK, CHUNK), w_s.dtype))
    mixed = jnp.einsum('gts,bcsgd->bctgd', w, vp) + b_s.T[None, None, :, :, None]
    mixed = mixed.reshape(B, n_c * CHUNK, D_A)[:, :T]
    return u * mixed, v


def compress(k_raw, pe, w1, b1, w2, n_cmp):
    B = k_raw.shape[0]
    n_seg = n_cmp + CMP_RATIO - 1
    seg = k_raw[:, :n_seg * CMP_STRIDE].reshape(B, n_seg, CMP_STRIDE, N_KV, HEAD_DIM)
    seg = seg.transpose(0, 1, 3, 2, 4).reshape(B, n_seg, N_KV, CMP_STRIDE * HEAD_DIM)
    w1r = w1.reshape(CMP_RATIO, CMP_STRIDE * HEAD_DIM, CMP_HIDDEN)
    pe_r = pe.reshape(CMP_RATIO, CMP_STRIDE * HEAD_DIM)
    part = jnp.einsum('bnhx,rxk->bnhrk', seg, w1r) + jnp.einsum('rx,rxk->rk', pe_r, w1r)
    acc = b1
    for r in range(CMP_RATIO):
        acc = acc + part[:, r:r + n_cmp, :, r]
    return jax.nn.gelu(acc) @ w2


def cmp_attend(q, kc, vc, tq):
    n_cmp = kc.shape[1]
    s = jnp.einsum('bthgd,bnhd->bhgtn', q, kc) * SCALE
    end = jnp.arange(n_cmp) * CMP_STRIDE + CMP_BLOCK - 1
    p = masked_softmax(s, end[None, :] <= tq[:, None])
    return jnp.einsum('bhgtn,bnhd->bthgd', p.astype(vc.dtype), vc), p


def select_blocks(p, tq, n_cmp, n_slc):
    i = jnp.arange(n_cmp)[:, None]
    j = jnp.arange(n_slc)[None, :]
    start = i * CMP_STRIDE
    overlap = ((start <= j * SLC_BLOCK + SLC_BLOCK - 1) & (start + CMP_BLOCK - 1 >= j * SLC_BLOCK)).astype(jnp.float32)
    imp = jnp.einsum('bhgtn,nj->bhtj', p, overlap)
    tb = (tq // SLC_BLOCK)[:, None]
    valid = j * SLC_BLOCK <= tq[:, None]
    forced = (j == 0) | (j == tb) | (j == tb - 1)
    score = jnp.where(forced, FORCE, jnp.where(valid, imp, NEG))
    _, sel = lax.top_k(score, min(TOP_N, n_slc))
    return sel


def sel_attend(q, kb, vb, kpos, tq):
    B, T = q.shape[:2]
    kb = kb.reshape(B, N_KV, T, -1, HEAD_DIM)
    vb = vb.reshape(B, N_KV, T, -1, HEAD_DIM)
    kpos = kpos.reshape(B, N_KV, T, -1)
    s = jnp.einsum('bthgd,bhtkd->bhgtk', q, kb) * SCALE
    p = masked_softmax(s, (kpos <= tq[None, None, :, None])[:, :, None])
    return jnp.einsum('bhgtk,bhtkd->bthgd', p.astype(vb.dtype), vb)


def win_attend(q, k, v, tq, kpos):
    s = jnp.einsum('bthgd,bkhd->bhgtk', q, k) * SCALE
    dist = tq[:, None] - kpos[None, :]
    mask = (dist >= 0) & (dist < WINDOW) & (kpos[None, :] >= 0)
    p = masked_softmax(s, mask)
    return jnp.einsum('bhgtk,bkhd->bthgd', p.astype(v.dtype), v)


def combine(g, o_cmp, o_slc, o_win):
    B, T = g.shape[:2]
    o = g[..., 0:1] * o_cmp + g[..., 1:2] * o_slc + g[..., 2:3] * o_win
    return o.reshape(B, T, D_B)


def merge(a, z_a, b, z_b, w_out):
    return jnp.concatenate([a * jax.nn.silu(z_a), b * jax.nn.silu(z_b)], axis=-1) @ w_out


def nsa_prompt(q, kv, g, pe, w1, b1, w2, win_buf):
    B, T = q.shape[:2]
    tq = jnp.arange(T)
    kc, vc, ks, vs, kw, vw = (kv[:, :, i] for i in range(6))
    qr, ks, kw = rope(q, tq), rope(ks, tq), rope(kw, tq)
    n_cmp = (T - CMP_BLOCK) // CMP_STRIDE + 1
    kcmp = compress(kc, pe[0], w1[0], b1[0], w2[0], n_cmp)
    vcmp = compress(vc, pe[1], w1[1], b1[1], w2[1], n_cmp)
    o_cmp, p = cmp_attend(q, kcmp, vcmp, tq)
    n_slc = -(-T // SLC_BLOCK)
    sel = select_blocks(p, tq, n_cmp, n_slc)
    ks_blk = ks.reshape(B, n_slc, SLC_BLOCK, N_KV, HEAD_DIM)
    vs_blk = vs.reshape(B, n_slc, SLC_BLOCK, N_KV, HEAD_DIM)
    bi = jnp.arange(B)[:, None, None, None]
    hi = jnp.arange(N_KV)[None, :, None, None]
    nq = T // Q_BLOCK

    def sel_block(args):
        qb, selb, tb = args
        kb = ks_blk[bi, selb, :, hi]
        vb = vs_blk[bi, selb, :, hi]
        kpos = selb[..., None] * SLC_BLOCK + jnp.arange(SLC_BLOCK)
        return sel_attend(qb, kb, vb, kpos, tb)

    o_slc = lax.map(sel_block, (qr.reshape(B, nq, Q_BLOCK, N_KV, GQA, HEAD_DIM).swapaxes(0, 1),
                                sel.reshape(B, N_KV, nq, Q_BLOCK, -1).transpose(2, 0, 1, 3, 4),
                                tq.reshape(nq, Q_BLOCK)))
    o_slc = o_slc.swapaxes(0, 1).reshape(B, T, N_KV, GQA, HEAD_DIM)
    kvw = jnp.stack([kw, vw], axis=2)
    kvw_pad = jnp.pad(kvw, ((0, 0), (WINDOW, 0), (0, 0), (0, 0), (0, 0)))
    nb = T // WIN_QBLOCK

    def win_block(args):
        qb, b0 = args
        kvb = lax.dynamic_slice_in_dim(kvw_pad, b0, WIN_QBLOCK + WINDOW, axis=1)
        tb = b0 + jnp.arange(WIN_QBLOCK)
        kpos = b0 - WINDOW + jnp.arange(WIN_QBLOCK + WINDOW)
        return win_attend(qb, kvb[:, :, 0], kvb[:, :, 1], tb, kpos)

    o_win = lax.map(win_block, (qr.reshape(B, nb, WIN_QBLOCK, N_KV, GQA, HEAD_DIM).swapaxes(0, 1),
                                jnp.arange(nb) * WIN_QBLOCK))
    o_win = o_win.swapaxes(0, 1).reshape(B, T, N_KV, GQA, HEAD_DIM)
    rows = jnp.stack([kc, vc, ks, vs], axis=2)
    win_state = kvw_pad[:, -win_buf:]
    return combine(g, o_cmp, o_slc, o_win), rows, win_state


def nsa_sample(q, kv, g, cache_kv, layer, page_table, win_prev, pe, w1, b1, w2):
    Bd, T = q.shape[:2]
    tq = PAST_LEN + jnp.arange(T)
    L = PAST_LEN + T
    n_pages = PAST_LEN // PAGE_SIZE
    kc, vc, ks, vs, kw, vw = (kv[:, :, i] for i in range(6))
    qr, ks, kw = rope(q, tq), rope(ks, tq), rope(kw, tq)
    past = cache_kv[layer, page_table, :, 0:2].reshape(Bd, PAST_LEN, 2, N_KV, HEAD_DIM)
    full = jnp.concatenate([past, jnp.stack([kc, vc], axis=2)], axis=1)
    n_cmp = (L - CMP_BLOCK) // CMP_STRIDE + 1
    kcmp = compress(full[:, :, 0], pe[0], w1[0], b1[0], w2[0], n_cmp)
    vcmp = compress(full[:, :, 1], pe[1], w1[1], b1[1], w2[1], n_cmp)
    o_cmp, p = cmp_attend(q, kcmp, vcmp, tq)
    n_slc = -(-L // SLC_BLOCK)
    sel = select_blocks(p, tq, n_cmp, n_slc)
    pos = sel[..., None] * SLC_BLOCK + jnp.arange(SLC_BLOCK)
    bi = jnp.arange(Bd)[:, None, None, None, None]
    hi = jnp.arange(N_KV)[None, :, None, None, None]
    phys = page_table[bi, jnp.minimum(pos // PAGE_SIZE, n_pages - 1)]
    off = pos % PAGE_SIZE
    from_past = (pos < PAST_LEN)[..., None]
    new_i = jnp.clip(pos - PAST_LEN, 0, T - 1)
    kb = jnp.where(from_past, cache_kv[layer, phys, off, 2, hi], ks[bi, new_i, hi])
    vb = jnp.where(from_past, cache_kv[layer, phys, off, 3, hi], vs[bi, new_i, hi])
    o_slc = sel_attend(qr, kb, vb, pos, tq)
    win_buf = win_prev.shape[1]
    buf = jnp.concatenate([win_prev, jnp.stack([kw, vw], axis=2)], axis=1)
    kpos = PAST_LEN - win_buf + jnp.arange(win_buf + T)
    o_win = win_attend(qr, buf[:, :, 0], buf[:, :, 1], tq, kpos)
    rows = jnp.stack([kc, vc, ks, vs], axis=2)
    return combine(g, o_cmp, o_slc, o_win), rows, buf[:, -win_buf:]


def setup_inputs(seed: int = 0) -> dict:
    key = jax.random.key(seed)
    ks = jax.random.split(key, 17)
    n_pages = PAST_LEN // PAGE_SIZE
    n_used = DEC_BATCH * n_pages
    n_phys = n_used + max(1, n_used // 4)
    win_buf = min(WINDOW, PAST_LEN)

    def nrm(k, shape, scale):
        return jax.random.normal(k, shape, jnp.float32) * scale

    perm = jax.random.permutation(ks[4], n_phys)
    return {
        'x_prompt': nrm(ks[0], (BATCH, SEQ, D_MODEL), 1.0),
        'x_sample': nrm(ks[1], (DEC_BATCH, DEC_SEQ, D_MODEL), 1.0),
        'cache_kv': nrm(ks[2], (DEPTH, n_phys, PAGE_SIZE, 4, N_KV, HEAD_DIM), 1.0),
        'state_win': nrm(ks[3], (DEPTH, DEC_BATCH, win_buf, 2, N_KV, HEAD_DIM), 1.0),
        'page_table': perm[:n_used].reshape(DEC_BATCH, n_pages).astype(jnp.int32),
        'norm_g': 1.0 + nrm(ks[5], (DEPTH, D_MODEL), 0.02),
        'w_in': nrm(ks[6], (DEPTH, D_MODEL, D_IN), D_MODEL ** -0.5),
        'ln_g': 1.0 + nrm(ks[7], (DEPTH, D_A), 0.02),
        'ln_b': nrm(ks[8], (DEPTH, D_A), 0.02),
        'w_s': nrm(ks[9], (DEPTH, A_GROUPS, CHUNK, CHUNK), CHUNK ** -0.5),
        'b_s': 1.0 + nrm(ks[10], (DEPTH, A_GROUPS, CHUNK), 0.1),
        'cmp_pos': nrm(ks[11], (DEPTH, 2, CMP_BLOCK, HEAD_DIM), 0.1),
        'w_cmp1': nrm(ks[12], (DEPTH, 2, CMP_BLOCK * HEAD_DIM, CMP_HIDDEN), (CMP_BLOCK * HEAD_DIM) ** -0.5),
        'b_cmp1': nrm(ks[13], (DEPTH, 2, CMP_HIDDEN), 0.02),
        'w_cmp2': nrm(ks[14], (DEPTH, 2, CMP_HIDDEN, HEAD_DIM), CMP_HIDDEN ** -0.5),
        'w_out': nrm(ks[15], (DEPTH, D_MIX, D_MODEL), D_MIX ** -0.5),
        'final_g': 1.0 + nrm(ks[16], (D_MODEL,), 0.02),
    }


def reference(x_prompt, x_sample, cache_kv, state_win, page_table, norm_g, w_in, ln_g, ln_b,
              w_s, b_s, cmp_pos, w_cmp1, b_cmp1, w_cmp2, w_out, final_g):
    win_buf = min(WINDOW, PAST_LEN)
    x_p, x_s = x_prompt, x_sample
    kv_p, win_p, kv_s, win_s, v_s = [], [], [], [], []
    for l in range(DEPTH):
        u, v, z_a, q, kv, g, z_b = project(x_p, norm_g[l], w_in[l])
        a_out, _ = chunk_gmlp(u, v, ln_g[l], ln_b[l], w_s[l], b_s[l])
        b_out, rows, win = nsa_prompt(q, kv, g, cmp_pos[l], w_cmp1[l], b_cmp1[l], w_cmp2[l], win_buf)
        x_p = x_p + merge(a_out, z_a, b_out, z_b, w_out[l])
        kv_p.append(rows)
        win_p.append(win)
        u, v, z_a, q, kv, g, z_b = project(x_s, norm_g[l], w_in[l])
        a_out, v_rows = chunk_gmlp(u, v, ln_g[l], ln_b[l], w_s[l], b_s[l])
        b_out, rows, win = nsa_sample(q, kv, g, cache_kv, l, page_table, state_win[l],
                                      cmp_pos[l], w_cmp1[l], b_cmp1[l], w_cmp2[l])
        x_s = x_s + merge(a_out, z_a, b_out, z_b, w_out[l])
        kv_s.append(rows)
        win_s.append(win)
        v_s.append(v_rows)
    y_prompt = rmsnorm(x_p, final_g)
    y_sample = rmsnorm(x_s, final_g)
    return (y_prompt, y_sample, jnp.stack(kv_p), jnp.stack(win_p), jnp.stack(kv_s), jnp.stack(win_s), jnp.stack(v_s))
```

```cpp
#include <hip/hip_runtime.h>
#include <stdint.h>

typedef float f32x4 __attribute__((ext_vector_type(4)));

namespace {
constexpr int D_MODEL = 1024, BATCH = 8, SEQ = 2048, DEC_B = 32, DEC_T = 8, PAST = 16384, PAGE = 128, NPAGES = 128;
constexpr int NPROMPT = BATCH * SEQ, NSAMP = DEC_B * DEC_T, NTOK = NPROMPT + NSAMP;
constexpr int D_IN = 3352;
constexpr int C_U = 0, C_V = 512, C_ZA = 1024, C_Q = 1536, C_KC = 2048, C_VC = 2176, C_KS = 2304, C_VS = 2432, C_KW = 2560, C_VW = 2688, C_G = 2816, C_ZB = 2840;
constexpr float EPS = 1e-6f, SCALE = 0.125f, NEGF = -1e30f, FORCEF = 1e9f;
constexpr size_t O_YP = 0, O_YS = 16777216, O_KVP = 17039360, O_WINP = 25427968, O_KVS = 26476544, O_WINS = 26607616, O_VS = 30801920;

struct Params {
    const float *x_prompt, *x_sample, *cache, *state_win; const int* page_table;
    const float *norm_g, *w_in, *ln_g, *ln_b, *w_s, *b_s, *cmp_pos, *w_cmp1, *b_cmp1, *w_cmp2, *w_out, *final_g;
    float* out;
    float *hn, *P, *QR, *mrg, *ypre, *rope, *hidp, *hids, *ckp, *cks;
};

__device__ __forceinline__ float gelu_tanh(float x) { const float u = 0.7978845608028654f * (x + 0.044715f * x * x * x); return 0.5f * x * (1.0f + tanhf(u)); }
__device__ __forceinline__ float sigmoidf_(float x) { return 1.0f / (1.0f + expf(-x)); }
__device__ __forceinline__ float silu_(float x) { return x * sigmoidf_(x); }
__device__ __forceinline__ float wave_sum(float v) { for (int o = 32; o > 0; o >>= 1) v += __shfl_xor(v, o); return v; }
__device__ __forceinline__ float wave_max(float v) { for (int o = 32; o > 0; o >>= 1) v = fmaxf(v, __shfl_xor(v, o)); return v; }

__device__ __forceinline__ const float* xrow(const Params& p, int r) { return r < NPROMPT ? p.x_prompt + (size_t)r * D_MODEL : p.x_sample + (size_t)(r - NPROMPT) * D_MODEL; }

__global__ void k_rope(Params p) {
    const int idx = blockIdx.x * blockDim.x + threadIdx.x; if (idx >= 2056 * 32) return;
    const int pi = idx / 32, i = idx % 32; const double pos = pi < 2048 ? (double)pi : (double)(PAST + pi - 2048);
    const double inv = pow(10000.0, -(double)i / 32.0), a = pos * inv;
    p.rope[2 * idx] = (float)cos(a); p.rope[2 * idx + 1] = (float)sin(a);
}
__global__ __launch_bounds__(256) void k_rms(Params p) {
    const int r = blockIdx.x, t = threadIdx.x; __shared__ float red[4];
    const float4 v = *(const float4*)(xrow(p, r) + t * 4);
    float s = wave_sum(v.x * v.x + v.y * v.y + v.z * v.z + v.w * v.w);
    if ((t & 63) == 0) red[t >> 6] = s; __syncthreads();
    s = red[0] + red[1] + red[2] + red[3];
    const float rs = 1.0f / sqrtf(s * (1.0f / D_MODEL) + EPS); const float4 g = *(const float4*)(p.norm_g + t * 4);
    float4 o; o.x = v.x * rs * g.x; o.y = v.y * rs * g.y; o.z = v.z * rs * g.z; o.w = v.w * rs * g.w;
    *(float4*)(p.hn + (size_t)r * D_MODEL + t * 4) = o;
}
template <class F> __global__ __launch_bounds__(256) void k_gemm(Params p, int M, int N, int K, F f) {
    __shared__ float As[16][132]; __shared__ float Bs[16][132];
    const int tid = threadIdx.x, lane = tid & 63, wid = tid >> 6, wm = wid >> 1, wn = wid & 1, z = blockIdx.z;
    const int m0 = blockIdx.y * 128, n0 = blockIdx.x * 128;
    f32x4 acc[4][4];
    for (int i = 0; i < 4; ++i) for (int j = 0; j < 4; ++j) acc[i][j] = (f32x4){0.f, 0.f, 0.f, 0.f};
    const int ar = tid >> 1, ak = (tid & 1) * 8, bk = tid >> 4, bn = (tid & 15) * 8;
    for (int k0 = 0; k0 < K; k0 += 16) {
        const float4 a0 = f.la(p, z, m0 + ar, k0 + ak), a1 = f.la(p, z, m0 + ar, k0 + ak + 4);
        const float4 b0 = f.lb(p, z, k0 + bk, n0 + bn, N), b1 = f.lb(p, z, k0 + bk, n0 + bn + 4, N);
        As[ak + 0][ar] = a0.x; As[ak + 1][ar] = a0.y; As[ak + 2][ar] = a0.z; As[ak + 3][ar] = a0.w;
        As[ak + 4][ar] = a1.x; As[ak + 5][ar] = a1.y; As[ak + 6][ar] = a1.z; As[ak + 7][ar] = a1.w;
        *(float4*)&Bs[bk][bn] = b0; *(float4*)&Bs[bk][bn + 4] = b1;
        __syncthreads();
#pragma unroll
        for (int ks = 0; ks < 16; ks += 4) {
            float a[4], b[4];
#pragma unroll
            for (int i = 0; i < 4; ++i) { a[i] = As[ks + (lane >> 4)][wm * 64 + i * 16 + (lane & 15)]; b[i] = Bs[ks + (lane >> 4)][wn * 64 + i * 16 + (lane & 15)]; }
#pragma unroll
            for (int i = 0; i < 4; ++i)
#pragma unroll
                for (int j = 0; j < 4; ++j) acc[i][j] = __builtin_amdgcn_mfma_f32_16x16x4f32(a[i], b[j], acc[i][j], 0, 0, 0);
        }
        __syncthreads();
    }
#pragma unroll
    for (int i = 0; i < 4; ++i)
#pragma unroll
      for (int j = 0; j < 4; ++j)
#pragma unroll
        for (int r = 0; r < 4; ++r) {
        const int row = m0 + wm * 64 + i * 16 + (lane >> 4) * 4 + r, col = n0 + wn * 64 + j * 16 + (lane & 15);
        if (row < M && col < N) f.ep(p, z, row, col, acc[i][j][r]);
    }
}
__device__ __forceinline__ float4 ld4(const float* q) { return *(const float4*)q; }
__device__ __forceinline__ float4 zero4() { return make_float4(0.f, 0.f, 0.f, 0.f); }
struct FInProj { int pad;
    __device__ float4 la(const Params& p, int, int r, int k) const { return ld4(p.hn + (size_t)r * D_MODEL + k); }
    __device__ float4 lb(const Params& p, int, int k, int n, int N) const { return n < N ? ld4(p.w_in + (size_t)k * D_IN + n) : zero4(); }
    __device__ void ep(const Params& p, int, int r, int c, float v) const { p.P[(size_t)r * D_IN + c] = v; }
};
struct FMerge { int pad;
    __device__ float4 la(const Params& p, int, int r, int k) const { return ld4(p.mrg + (size_t)r * D_MODEL + k); }
    __device__ float4 lb(const Params& p, int, int k, int n, int) const { return ld4(p.w_out + (size_t)k * D_MODEL + n); }
    __device__ void ep(const Params& p, int, int r, int c, float v) const { p.ypre[(size_t)r * D_MODEL + c] = xrow(p, r)[c] + v; }
};
template <bool SAMPLE> struct FCmp { int pad;
    static constexpr int NB = SAMPLE ? 1024 : 128, NC = SAMPLE ? 1023 : 127;
    __device__ float4 la(const Params& p, int kv, int r, int x) const {
        const int seq = r / NB, i = r % NB, b = seq >> 1, h = seq & 1; if (i >= NC) return zero4();
        const int tok = 16 * i + (x >> 6), d = x & 63; float4 v;
        if (SAMPLE) { const int phys = p.page_table[b * NPAGES + (tok >> 7)], off = tok & 127; v = ld4(p.cache + ((((size_t)phys * PAGE + off) * 4 + kv) * 2 + h) * 64 + d); }
        else v = ld4(p.P + (size_t)(b * SEQ + tok) * D_IN + C_KC + kv * 128 + h * 64 + d);
        const float4 pe = ld4(p.cmp_pos + kv * 2048 + x); v.x += pe.x; v.y += pe.y; v.z += pe.z; v.w += pe.w; return v;
    }
    __device__ float4 lb(const Params& p, int kv, int k, int n, int) const { return ld4(p.w_cmp1 + ((size_t)kv * 2048 + k) * 128 + n); }
    __device__ void ep(const Params& p, int kv, int r, int c, float v) const {
        float* hid = SAMPLE ? p.hids : p.hidp; const int M = SAMPLE ? 65536 : 2048;
        hid[((size_t)kv * M + r) * 128 + c] = gelu_tanh(v + p.b_cmp1[kv * 128 + c]);
    }
};
__global__ __launch_bounds__(256) void k_cmp2(Params p, int M, int sample) {
    const size_t idx = (size_t)blockIdx.x * 256 + threadIdx.x; const int d = idx & 63; const size_t rr = idx >> 6; if (rr >= (size_t)2 * M) return;
    const int kv = (int)(rr / M); const float* hid = (sample ? p.hids : p.hidp) + rr * 128; const float* w2 = p.w_cmp2 + (size_t)kv * 128 * 64 + d;
    float s = 0.f; for (int k = 0; k < 128; ++k) s += hid[k] * w2[k * 64];
    (sample ? p.cks : p.ckp)[rr * 64 + d] = s;
}
__global__ __launch_bounds__(256) void k_proj_epi(Params p) {
    const int r = blockIdx.x, t = threadIdx.x; float* P = p.P + (size_t)r * D_IN; __shared__ float red[8];
    const bool samp = r >= NPROMPT; const int b = samp ? (r - NPROMPT) / DEC_T : r / SEQ, tt = samp ? (r - NPROMPT) % DEC_T : r % SEQ;
    const float* rp = p.rope + (size_t)(samp ? 2048 + tt : tt) * 64;
    for (int c = t; c < 512; c += 256) { P[C_U + c] = gelu_tanh(P[C_U + c]); P[C_ZA + c] = silu_(P[C_ZA + c]); P[C_ZB + c] = silu_(P[C_ZB + c]); }
    if (t < 24) P[C_G + t] = sigmoidf_(P[C_G + t]);
    const float v0 = gelu_tanh(P[C_V + t]), v1 = gelu_tanh(P[C_V + 256 + t]);
    float s = wave_sum(v0 + v1); if ((t & 63) == 0) red[t >> 6] = s; __syncthreads();
    const float mu = (red[0] + red[1] + red[2] + red[3]) * (1.0f / 512.0f);
    const float d0 = v0 - mu, d1 = v1 - mu; float q = wave_sum(d0 * d0 + d1 * d1); if ((t & 63) == 0) red[4 + (t >> 6)] = q; __syncthreads();
    const float rs = 1.0f / sqrtf((red[4] + red[5] + red[6] + red[7]) * (1.0f / 512.0f) + EPS);
    const float n0 = d0 * rs * p.ln_g[t] + p.ln_b[t], n1 = d1 * rs * p.ln_g[256 + t] + p.ln_b[256 + t];
    P[C_V + t] = n0; P[C_V + 256 + t] = n1;
    if (samp) { float* o = p.out + O_VS + (size_t)(r - NPROMPT) * 512; o[t] = n0; o[256 + t] = n1; }
    { const int hh = t >> 5, i = t & 31; const float c = rp[2 * i], sn = rp[2 * i + 1]; const float x1 = P[C_Q + hh * 64 + i], x2 = P[C_Q + hh * 64 + 32 + i];
      float* q = p.QR + (size_t)r * 512 + hh * 64; q[i] = x1 * c - x2 * sn; q[32 + i] = x2 * c + x1 * sn; }
    if (t < 128) { const int which = t >> 6, h = (t >> 5) & 1, i = t & 31; const int base = (which ? C_KW : C_KS) + h * 64; const float c = rp[2 * i], sn = rp[2 * i + 1];
      const float x1 = P[base + i], x2 = P[base + 32 + i]; P[base + i] = x1 * c - x2 * sn; P[base + 32 + i] = x2 * c + x1 * sn; }
    __syncthreads();
    { float* o = p.out + (samp ? O_KVS + (size_t)(r - NPROMPT) * 512 : O_KVP + (size_t)r * 512); o[t] = P[C_KC + t]; o[256 + t] = P[C_KC + 256 + t]; }
    if (!samp) { if (tt >= SEQ - 512) p.out[O_WINP + ((size_t)b * 512 + (tt - (SEQ - 512))) * 256 + t] = P[C_KW + t]; }
    else {
        float* w = p.out + O_WINS + (size_t)b * 512 * 256; w[(size_t)(504 + tt) * 256 + t] = P[C_KW + t];
        const float* sw = p.state_win + (size_t)b * 512 * 256;
        for (int j = tt * 63; j < tt * 63 + 63; ++j) w[(size_t)j * 256 + t] = sw[(size_t)(j + 8) * 256 + t];
    }
}
__global__ __launch_bounds__(256) void k_gmlp(Params p) {
    const int ch = blockIdx.x, g = blockIdx.y, tid = threadIdx.x; __shared__ float vn[128][64];
    const int r0 = ch < 128 ? ch * 128 : NPROMPT + (ch - 128) * DEC_T, T = ch < 128 ? 128 : DEC_T;
    for (int idx = tid; idx < T * 64; idx += 256) vn[idx >> 6][idx & 63] = p.P[(size_t)(r0 + (idx >> 6)) * D_IN + C_V + g * 64 + (idx & 63)];
    __syncthreads();
    for (int idx = tid; idx < T * 64; idx += 256) {
        const int t = idx >> 6, d = idx & 63; const float* w = p.w_s + ((size_t)g * 128 + t) * 128; float acc = 0.f;
        for (int s = 0; s <= t; ++s) acc += w[s] * vn[s][d];
        const float mixed = acc + p.b_s[g * 128 + t]; const float* P = p.P + (size_t)(r0 + t) * D_IN;
        p.mrg[(size_t)(r0 + t) * D_MODEL + g * 64 + d] = P[C_U + g * 64 + d] * mixed * P[C_ZA + g * 64 + d];
    }
}
struct Soft { float m, l, o; };
__device__ __forceinline__ void tile_step(Soft& st, const float (*Kt)[65], const float (*Vt)[64], const float* q, float* ps, bool valid, int lane) {
    float s = 0.f;
#pragma unroll 16
    for (int d = 0; d < 64; ++d) s += q[d] * Kt[lane][d];
    s = valid ? s * SCALE : NEGF;
    const float mn = fmaxf(st.m, wave_max(s)), sc = expf(st.m - mn), pr = valid ? expf(s - mn) : 0.f;
    st.l = st.l * sc + wave_sum(pr); st.m = mn; ps[lane] = pr;
    __syncthreads();
    float o = st.o * sc;
#pragma unroll 16
    for (int k = 0; k < 64; ++k) o += ps[k] * Vt[k][lane];
    st.o = o;
    __syncthreads();
}
template <bool SAMPLE> __global__ __launch_bounds__(256) void k_attn(Params p) {
    constexpr int NC = SAMPLE ? 1023 : 127, NCB = SAMPLE ? 1024 : 128, NS = SAMPLE ? 257 : 32, T = SAMPLE ? DEC_T : SEQ;
    __shared__ float sc[4][NCB]; __shared__ float Kt[64][65]; __shared__ float Vt[64][64]; __shared__ float qs[4][64], qrs[4][64], ps[4][64];
    __shared__ float score[NS + 3]; __shared__ int sel[16];
    const int tid = threadIdx.x, lane = tid & 63, g = tid >> 6;
    const int bid = blockIdx.x, t = bid % T, h = (bid / T) & 1, b = bid / (2 * T);
    const int r = SAMPLE ? NPROMPT + b * DEC_T + t : b * SEQ + t, tq = SAMPLE ? PAST + t : t, seq = b * 2 + h, hh = h * 4 + g;
    const float* Pr = p.P + (size_t)r * D_IN;
    qs[g][lane] = Pr[C_Q + hh * 64 + lane]; qrs[g][lane] = p.QR[(size_t)r * 512 + hh * 64 + lane];
    __syncthreads();
    const float* CK = (SAMPLE ? p.cks : p.ckp) + (size_t)seq * NCB * 64; const float* CV = CK + (size_t)(SAMPLE ? 65536 : 2048) * 64;
    float mx = NEGF;
    for (int i = lane; i < NC; i += 64) { float s = 0.f; const float* k = CK + (size_t)i * 64; for (int d = 0; d < 64; ++d) s += qs[g][d] * k[d];
        s = (16 * i + 31 <= tq) ? s * SCALE : NEGF; sc[g][i] = s; mx = fmaxf(mx, s); }
    mx = wave_max(mx); float sum = 0.f;
    for (int i = lane; i < NC; i += 64) { const float e = (16 * i + 31 <= tq) ? expf(sc[g][i] - mx) : 0.f; sc[g][i] = e; sum += e; }
    sum = wave_sum(sum); const float inv = 1.0f / fmaxf(sum, 1.0f);
    for (int i = lane; i < NC; i += 64) sc[g][i] *= inv;
    __syncthreads();
    float ocmp = 0.f; for (int i = 0; i < NC; ++i) ocmp += sc[g][i] * CV[(size_t)i * 64 + lane];
    __syncthreads();
    const int tb = tq >> 6;
    for (int j = tid; j < NS; j += 256) { float im = 0.f; const int lo = max(0, 4 * j - 1), hi = min(NC - 1, 4 * j + 3);
        for (int i = lo; i <= hi; ++i) im += (sc[0][i] + sc[1][i]) + (sc[2][i] + sc[3][i]);
        const bool forced = (j == 0) || (j == tb) || (j == tb - 1), valid = j * 64 <= tq; score[j] = forced ? FORCEF : (valid ? im : NEGF); }
    __syncthreads();
    for (int j = tid; j < NS; j += 256) { const float sj = score[j]; int rank = 0; for (int k = 0; k < NS; ++k) { const float sk = score[k]; rank += (sk > sj || (sk == sj && k < j)) ? 1 : 0; }
        if (rank < 16) sel[rank] = j; }
    __syncthreads();
    Soft ss{NEGF, 0.f, 0.f};
    for (int s = 0; s < 16; ++s) {
        const int blk = sel[s];
        for (int idx = tid; idx < 64 * 16; idx += 256) { const int k = idx >> 4, d4 = (idx & 15) * 4, pos = blk * 64 + k; const float *kp, *vp;
            if (SAMPLE) { if (pos < PAST) { const int phys = p.page_table[b * NPAGES + (pos >> 7)], off = pos & 127; kp = p.cache + ((((size_t)phys * PAGE + off) * 4 + 2) * 2 + h) * 64; vp = kp + 128; }
                          else { const int ni = min(pos - PAST, DEC_T - 1); kp = p.P + (size_t)(NPROMPT + b * DEC_T + ni) * D_IN + C_KS + h * 64; vp = kp + 128; } }
            else { kp = p.P + (size_t)(b * SEQ + pos) * D_IN + C_KS + h * 64; vp = kp + 128; }
            const float4 kv = ld4(kp + d4), vv = ld4(vp + d4); Kt[k][d4] = kv.x; Kt[k][d4 + 1] = kv.y; Kt[k][d4 + 2] = kv.z; Kt[k][d4 + 3] = kv.w; *(float4*)&Vt[k][d4] = vv; }
        __syncthreads();
        tile_step(ss, Kt, Vt, qrs[g], ps[g], blk * 64 + lane <= tq, lane);
        __syncthreads();
    }
    const float oslc = ss.o / fmaxf(ss.l, 1.0f);
    Soft sw{NEGF, 0.f, 0.f};
    const int c_lo = SAMPLE ? 0 : max(0, tq - 511) >> 6, c_hi = SAMPLE ? 8 : tq >> 6;
    for (int c = c_lo; c <= c_hi; ++c) {
        for (int idx = tid; idx < 64 * 16; idx += 256) { const int k = idx >> 4, d4 = (idx & 15) * 4, pos = c * 64 + k; const float *kp, *vp;
            if (SAMPLE) { if (pos < 512) { kp = p.state_win + ((((size_t)b * 512 + pos) * 2 + 0) * 2 + h) * 64; vp = kp + 128; }
                          else { const int ni = min(pos - 512, DEC_T - 1); kp = p.P + (size_t)(NPROMPT + b * DEC_T + ni) * D_IN + C_KW + h * 64; vp = kp + 128; } }
            else { kp = p.P + (size_t)(b * SEQ + pos) * D_IN + C_KW + h * 64; vp = kp + 128; }
            const float4 kv = ld4(kp + d4), vv = ld4(vp + d4); Kt[k][d4] = kv.x; Kt[k][d4 + 1] = kv.y; Kt[k][d4 + 2] = kv.z; Kt[k][d4 + 3] = kv.w; *(float4*)&Vt[k][d4] = vv; }
        __syncthreads();
        const int idx = c * 64 + lane; bool valid;
        if (SAMPLE) { const int kpos = PAST - 512 + idx, dist = tq - kpos; valid = idx < 520 && dist >= 0 && dist < 512; }
        else { const int dist = tq - idx; valid = dist >= 0 && dist < 512; }
        tile_step(sw, Kt, Vt, qrs[g], ps[g], valid, lane);
        __syncthreads();
    }
    const float owin = sw.o / fmaxf(sw.l, 1.0f);
    const float g0 = Pr[C_G + hh * 3], g1 = Pr[C_G + hh * 3 + 1], g2 = Pr[C_G + hh * 3 + 2];
    p.mrg[(size_t)r * D_MODEL + 512 + hh * 64 + lane] = (g0 * ocmp + g1 * oslc + g2 * owin) * Pr[C_ZB + hh * 64 + lane];
}
__global__ __launch_bounds__(256) void k_final(Params p) {
    const int r = blockIdx.x, t = threadIdx.x; __shared__ float red[4];
    const float4 v = *(const float4*)(p.ypre + (size_t)r * D_MODEL + t * 4);
    float s = wave_sum(v.x * v.x + v.y * v.y + v.z * v.z + v.w * v.w);
    if ((t & 63) == 0) red[t >> 6] = s; __syncthreads();
    s = red[0] + red[1] + red[2] + red[3];
    const float rs = 1.0f / sqrtf(s * (1.0f / D_MODEL) + EPS); const float4 g = *(const float4*)(p.final_g + t * 4);
    float4 o; o.x = v.x * rs * g.x; o.y = v.y * rs * g.y; o.z = v.z * rs * g.z; o.w = v.w * rs * g.w;
    *(float4*)(p.out + (size_t)r * D_MODEL + t * 4) = o;
}
}

extern "C" void kernel_launch(void* const* d_in, const int* in_sizes, int n_in, void* d_out, int out_size, void* d_ws, size_t ws_size, hipStream_t stream) {
    Params p{};
    p.x_prompt = (const float*)d_in[0]; p.x_sample = (const float*)d_in[1]; p.cache = (const float*)d_in[2]; p.state_win = (const float*)d_in[3]; p.page_table = (const int*)d_in[4];
    p.norm_g = (const float*)d_in[5]; p.w_in = (const float*)d_in[6]; p.ln_g = (const float*)d_in[7]; p.ln_b = (const float*)d_in[8]; p.w_s = (const float*)d_in[9]; p.b_s = (const float*)d_in[10];
    p.cmp_pos = (const float*)d_in[11]; p.w_cmp1 = (const float*)d_in[12]; p.b_cmp1 = (const float*)d_in[13]; p.w_cmp2 = (const float*)d_in[14]; p.w_out = (const float*)d_in[15]; p.final_g = (const float*)d_in[16];
    p.out = (float*)d_out;
    float* w = (float*)d_ws; size_t o = 0;
    auto take = [&](size_t n) { float* r = w + o; o += (n + 63) & ~(size_t)63; return r; };
    p.hn = take((size_t)NTOK * D_MODEL); p.P = take((size_t)NTOK * D_IN); p.QR = take((size_t)NTOK * 512); p.mrg = take((size_t)NTOK * D_MODEL); p.ypre = take((size_t)NTOK * D_MODEL);
    p.rope = take(2056 * 64); p.hidp = take((size_t)2 * 2048 * 128); p.hids = take((size_t)2 * 65536 * 128); p.ckp = take((size_t)2 * 2048 * 64); p.cks = take((size_t)2 * 65536 * 64);
    k_rope<<<(2056 * 32 + 255) / 256, 256, 0, stream>>>(p);
    k_rms<<<NTOK, 256, 0, stream>>>(p);
    k_gemm<<<dim3((D_IN + 127) / 128, NTOK / 128, 1), 256, 0, stream>>>(p, NTOK, D_IN, D_MODEL, FInProj{0});
    k_proj_epi<<<NTOK, 256, 0, stream>>>(p);
    k_gmlp<<<dim3(160, 8), 256, 0, stream>>>(p);
    k_gemm<<<dim3(1, 2048 / 128, 2), 256, 0, stream>>>(p, 2048, 128, 2048, FCmp<false>{0});
    k_gemm<<<dim3(1, 65536 / 128, 2), 256, 0, stream>>>(p, 65536, 128, 2048, FCmp<true>{0});
    k_cmp2<<<(2 * 2048 * 64) / 256, 256, 0, stream>>>(p, 2048, 0);
    k_cmp2<<<(2 * 65536 * 64) / 256, 256, 0, stream>>>(p, 65536, 1);
    k_attn<false><<<BATCH * 2 * SEQ, 256, 0, stream>>>(p);
    k_attn<true><<<DEC_B * 2 * DEC_T, 256, 0, stream>>>(p);
    k_gemm<<<dim3(D_MODEL / 128, NTOK / 128, 1), 256, 0, stream>>>(p, NTOK, D_MODEL, D_MODEL, FMerge{0});
    k_final<<<NTOK, 256, 0, stream>>>(p);
}
```

```cpp
#include <hip/hip_runtime.h>
#include <stdint.h>
#include <cstdio>

namespace pg8 {
#define PG8_LAS __attribute__((address_space(3)))
typedef unsigned short bf16_t;
typedef short bf16x8 __attribute__((ext_vector_type(8)));
typedef float f32x4 __attribute__((ext_vector_type(4)));
typedef unsigned u32x4 __attribute__((ext_vector_type(4)));
constexpr int BM = 256, BK = 64, HALF = 128, HTB = HALF * BK * 2  , STAGE_BYTES = 8 * HTB, NXCD = 8, WGM = 8;

__host__ __device__ __forceinline__ int lds_byte(int r, int c) { const int st = (r >> 4) * 2 + (c >> 5), rr = r & 15, cc = c & 31, ob = rr * 64 + cc * 2; return st * 1024 + (ob ^ (((ob >> 9) & 1) << 5)); }
__host__ __device__ __forceinline__ void stage_rc(int b, int& R, int& C) { const int st = b / 1024, sb = b % 1024, swz = sb ^ (((sb >> 9) & 1) << 5); R = (st >> 1) * 16 + swz / 64; C = (st & 1) * 32 + (swz % 64) / 2; }
__host__ __device__ __forceinline__ int perm32(int rho) { const int n = rho >> 4, i = rho & 15; return 8 * (i >> 2) + 4 * n + (i & 3); }

struct Unit { int pm, pn; };
struct Gemm { const bf16_t* A; const bf16_t* Bt; int M, N, K; };

struct StaticOrder {
    int nM, nN, nwg, G, c;
    __host__ __device__ void init(int M, int N, int G_, int c_) { nM = M / BM; nN = N / BM; nwg = nM * nN; G = G_; c = c_; }
    __host__ __device__ bool next(int i, Unit& u) const {
        const long L = (long)i * G + c; if (L >= nwg) return false;
        int wgid = (int)L; { const int q = nwg / NXCD, r = nwg % NXCD, xcd = wgid % NXCD, off = wgid / NXCD; wgid = (xcd < r ? xcd * (q + 1) : r * (q + 1) + (xcd - r) * q) + off; }
        const int nig = WGM * nN, gid = wgid / nig, fm = gid * WGM, gsz = (nM - fm) < WGM ? (nM - fm) : WGM;
        u.pm = fm + ((wgid % nig) % gsz); u.pn = (wgid % nig) / gsz; return true;
    }
    __device__ __forceinline__ void a_ready(const Unit&) const {}
    __device__ __forceinline__ void done(const Unit&) const {}
};

__device__ __forceinline__ unsigned cvt_pk_bf16(float lo, float hi) { unsigned r; asm volatile("v_cvt_pk_bf16_f32 %0, %1, %2" : "=v"(r) : "v"(lo), "v"(hi)); return r; }
template <class Epi, class Sched, bool ALIGN_EPI = false, bool SP2 = false>
__device__ __forceinline__ void gemm_phase(PG8_LAS unsigned char* lds, const Gemm g, const Sched& S, const Epi& E) {
    const int tid = threadIdx.x, wid = __builtin_amdgcn_readfirstlane(tid >> 6), lane = tid & 63, wr = wid >> 2, wc = wid & 3, fr = lane & 15, fq = lane >> 4;
    const int K = g.K, nt = K / BK;
    unsigned voffA[2], voffB[2];
#pragma unroll
    for (int i = 0; i < 2; ++i) { int R, C; stage_rc(tid * 16 + i * 8192, R, C); const int Rb = Epi::PERM ? ((R & ~31) + perm32(R & 31)) : R;
        voffA[i] = (unsigned)(R * K + C) * 2u; voffB[i] = (unsigned)(Rb * K + C) * 2u; }
    const size_t kstep = (size_t)(BK * 2);
    const size_t hstep = (size_t)HALF * K * 2;
    const size_t tstep = 2 * hstep;
    const unsigned ldsw = (unsigned)wid * 1024u;
    const int aoff = lds_byte(wr * 64 + fr, fq * 8), boff = lds_byte(wc * 32 + fr, fq * 8);
#define PG8_SA(b, h) (((b) * 2 + (h)) * HTB)
#define PG8_SB(b, h) ((4 + (b) * 2 + (h)) * HTB)
#define PG8_STAGE(bufoff, gbase, voff) do { _Pragma("unroll") for (int _i = 0; _i < 2; ++_i) \
        __builtin_amdgcn_global_load_lds((const unsigned*)((const char*)(gbase) + (voff)[_i]), (PG8_LAS unsigned*)(lds + (bufoff) + ldsw + _i * 8192), 16, 0, 0); } while (0)
#define PG8_LDA(dst, b, h) do { _Pragma("unroll") for (int m = 0; m < 4; ++m) _Pragma("unroll") for (int k = 0; k < 2; ++k) dst[m][k] = *(const PG8_LAS bf16x8*)(lds + PG8_SA(b, h) + aoff + m * 2048 + k * 1024); } while (0)
#define PG8_LDB(dst, b, h) do { _Pragma("unroll") for (int n = 0; n < 2; ++n) _Pragma("unroll") for (int k = 0; k < 2; ++k) dst[n][k] = *(const PG8_LAS bf16x8*)(lds + PG8_SB(b, h) + boff + n * 2048 + k * 1024); } while (0)
#define PG8_MMA(ai, bj, At, Bt) do { __builtin_amdgcn_s_setprio(1); _Pragma("unroll") for (int m = 0; m < 4; ++m) _Pragma("unroll") for (int n = 0; n < 2; ++n) _Pragma("unroll") for (int k = 0; k < 2; ++k) \
        acc[ai][bj][m][n] = __builtin_amdgcn_mfma_f32_16x16x32_bf16(Bt[n][k], At[m][k], acc[ai][bj][m][n], 0, 0, 0); __builtin_amdgcn_s_setprio(0); } while (0)
#define PG8_WAIT_V(n) asm volatile("s_waitcnt vmcnt(" #n ")" ::: "memory")
#define PG8_WAIT_L(n) asm volatile("s_waitcnt lgkmcnt(" #n ")" ::: "memory")
#define PG8_BAR __builtin_amdgcn_s_barrier()
#define PG8_SCHED __builtin_amdgcn_sched_barrier(0)
    Unit cur, nxt; int ui = 0;
    if (!S.next(0, cur)) return;
    f32x4 acc[2][2][4][2];
#pragma unroll
    for (int a = 0; a < 2; ++a)
#pragma unroll
        for (int b = 0; b < 2; ++b)
#pragma unroll
            for (int m = 0; m < 4; ++m)
#pragma unroll
                for (int n = 0; n < 2; ++n) acc[a][b][m][n] = (f32x4){0.f, 0.f, 0.f, 0.f};
    bf16x8 At[4][2], B0[2][2], B1[2][2];
    const char* cA = (const char*)g.A + (size_t)cur.pm * tstep; const char* cB = (const char*)g.Bt + (size_t)cur.pn * tstep;
    S.a_ready(cur);
    if constexpr (SP2) {
        PG8_STAGE(PG8_SB(0, 0), cB, voffB); PG8_STAGE(PG8_SB(0, 1), cB + hstep, voffB); PG8_STAGE(PG8_SA(0, 0), cA, voffA); PG8_STAGE(PG8_SA(0, 1), cA + hstep, voffA);
        if (wr == 1) PG8_BAR;
        PG8_WAIT_V(2); PG8_BAR;
        PG8_STAGE(PG8_SB(1, 0), cB + kstep, voffB); PG8_STAGE(PG8_SA(1, 0), cA + kstep, voffA); PG8_STAGE(PG8_SB(1, 1), cB + hstep + kstep, voffB);
        PG8_WAIT_V(6); PG8_BAR;
    } else {
        PG8_STAGE(PG8_SB(0, 0), cB, voffB); PG8_STAGE(PG8_SA(0, 0), cA, voffA); PG8_STAGE(PG8_SB(0, 1), cB + hstep, voffB); PG8_STAGE(PG8_SA(0, 1), cA + hstep, voffA);
        if (wr == 1) PG8_BAR;
        PG8_WAIT_V(4); PG8_BAR;
        PG8_STAGE(PG8_SB(1, 0), cB + kstep, voffB); PG8_STAGE(PG8_SA(1, 0), cA + kstep, voffA); PG8_STAGE(PG8_SB(1, 1), cB + hstep + kstep, voffB);
        PG8_WAIT_V(6); PG8_BAR;
    }
    for (;;) {
        const bool has_next = S.next(ui + 1, nxt);
        const char* nA = has_next ? (const char*)g.A + (size_t)nxt.pm * tstep : cA; const char* nB = has_next ? (const char*)g.Bt + (size_t)nxt.pn * tstep : cB;
        for (int t = 0; t < nt; t += 2) {
            const bool last = (t == nt - 2);
            const char* a1 = cA + (size_t)(t + 1) * kstep;
            const char* a2 = last ? nA : cA + (size_t)(t + 2) * kstep; const char* b2 = last ? nB : cB + (size_t)(t + 2) * kstep;
            const char* a3 = a2 + kstep; const char* b3 = b2 + kstep;
            if (last && has_next) S.a_ready(nxt);
            if constexpr (SP2) {
            PG8_LDB(B0, 0, 0); PG8_LDB(B1, 0, 1); PG8_SCHED; PG8_LDA(At, 0, 0); PG8_STAGE(PG8_SA(1, 1), a1 + hstep, voffA);
            PG8_WAIT_V(8); PG8_WAIT_L(0); PG8_BAR; PG8_MMA(0, 0, At, B0); PG8_MMA(0, 1, At, B1); PG8_BAR; PG8_SCHED;
            PG8_LDA(At, 0, 1); PG8_STAGE(PG8_SB(0, 0), b2, voffB); PG8_STAGE(PG8_SB(0, 1), b2 + hstep, voffB); PG8_STAGE(PG8_SA(0, 0), a2, voffA);
            PG8_WAIT_V(8); PG8_WAIT_L(0); PG8_BAR; PG8_MMA(1, 0, At, B0); PG8_MMA(1, 1, At, B1); PG8_BAR; PG8_SCHED;
            PG8_LDB(B0, 1, 0); PG8_LDB(B1, 1, 1); PG8_SCHED; PG8_LDA(At, 1, 0); PG8_STAGE(PG8_SA(0, 1), a2 + hstep, voffA);
            PG8_WAIT_V(8); PG8_WAIT_L(0); PG8_BAR; PG8_MMA(0, 0, At, B0); PG8_MMA(0, 1, At, B1); PG8_BAR; PG8_SCHED;
            PG8_LDA(At, 1, 1); PG8_STAGE(PG8_SB(1, 0), b3, voffB); PG8_STAGE(PG8_SB(1, 1), b3 + hstep, voffB); PG8_STAGE(PG8_SA(1, 0), a3, voffA);
            PG8_WAIT_V(8); PG8_WAIT_L(0); PG8_BAR; PG8_MMA(1, 0, At, B0); PG8_MMA(1, 1, At, B1); PG8_BAR; PG8_SCHED;
            } else {
            PG8_LDB(B0, 0, 0); PG8_SCHED; PG8_LDA(At, 0, 0); PG8_STAGE(PG8_SA(1, 1), a1 + hstep, voffA);
            PG8_WAIT_L(8); PG8_BAR; PG8_WAIT_L(0); PG8_MMA(0, 0, At, B0); PG8_BAR; PG8_SCHED;
            PG8_LDB(B1, 0, 1); PG8_STAGE(PG8_SB(0, 0), b2, voffB);
            PG8_BAR; PG8_WAIT_L(0); PG8_MMA(0, 1, At, B1); PG8_BAR;
            PG8_LDA(At, 0, 1); PG8_STAGE(PG8_SA(0, 0), a2, voffA);
            PG8_BAR; PG8_WAIT_L(0); PG8_MMA(1, 0, At, B0); PG8_BAR; PG8_SCHED;
            PG8_STAGE(PG8_SB(0, 1), b2 + hstep, voffB);
            PG8_WAIT_V(6); PG8_BAR; PG8_MMA(1, 1, At, B1); PG8_BAR;
            PG8_LDB(B0, 1, 0); PG8_SCHED; PG8_LDA(At, 1, 0); PG8_STAGE(PG8_SA(0, 1), a2 + hstep, voffA);
            PG8_WAIT_L(8); PG8_BAR; PG8_WAIT_L(0); PG8_MMA(0, 0, At, B0); PG8_BAR; PG8_SCHED;
            PG8_LDB(B1, 1, 1); PG8_STAGE(PG8_SB(1, 0), b3, voffB);
            PG8_BAR; PG8_WAIT_L(0); PG8_MMA(0, 1, At, B1); PG8_BAR;
            PG8_LDA(At, 1, 1); PG8_STAGE(PG8_SA(1, 0), a3, voffA);
            PG8_BAR; PG8_WAIT_L(0); PG8_MMA(1, 0, At, B0); PG8_BAR; PG8_SCHED;
            PG8_STAGE(PG8_SB(1, 1), b3 + hstep, voffB);
            PG8_WAIT_V(6); PG8_BAR; PG8_MMA(1, 1, At, B1); PG8_BAR;
            }
        }
        if constexpr (ALIGN_EPI) { if (wr == 0) PG8_BAR; }
        if constexpr (!Epi::AFTER_DRAIN) { E(acc, cur, wr, wc, fr, fq); S.done(cur); }
        if (!has_next) break;
#pragma unroll
        for (int a = 0; a < 2; ++a)
#pragma unroll
            for (int b = 0; b < 2; ++b)
#pragma unroll
                for (int m = 0; m < 4; ++m)
#pragma unroll
                    for (int n = 0; n < 2; ++n) acc[a][b][m][n] = (f32x4){0.f, 0.f, 0.f, 0.f};
        cur = nxt; cA = nA; cB = nB; ++ui;
        if constexpr (ALIGN_EPI) { if (wr == 1) PG8_BAR; }
    }
    PG8_WAIT_V(0);
    if constexpr (!ALIGN_EPI) { if (wr == 0) PG8_BAR; }
    PG8_BAR;
    if constexpr (Epi::AFTER_DRAIN) { E.fused(acc, cur, wr, wc, fr, fq, lds, wid, lane); S.done(cur); }
#undef PG8_SA
#undef PG8_SB
#undef PG8_STAGE
#undef PG8_LDA
#undef PG8_LDB
#undef PG8_MMA
#undef PG8_WAIT_V
#undef PG8_WAIT_L
#undef PG8_BAR
#undef PG8_SCHED
}
}

#define XB_TMO      128
#define XB_XCNT(j)  (256  + 64 * (j))
#define XB_XSUB(j)  (1280 + 64 * (j))
#define XB_XGEN(j)  (2304 + 64 * (j))
#define XB_TOP      3328
#define XB_TOPGEN   3392
#define XCD_BAR_WORDS 3456
#define XB_SPIN_CAP (1u << 18)
#define LAS __attribute__((address_space(3)))

__device__ __forceinline__ unsigned xb_ld(unsigned* p)              { return __hip_atomic_load(p, __ATOMIC_RELAXED, __HIP_MEMORY_SCOPE_AGENT); }
__device__ __forceinline__ unsigned xb_add(unsigned* p, unsigned v) { return __hip_atomic_fetch_add(p, v, __ATOMIC_RELAXED, __HIP_MEMORY_SCOPE_AGENT); }
__device__ __forceinline__ unsigned xb_xcc_id() { return (unsigned)__builtin_amdgcn_s_getreg((3 << 11) | 20) & 0xFu; }
#define XB_SPIN(cond, bar) do { unsigned _sp = 0; while (cond) { __builtin_amdgcn_s_sleep(1); \
    if ((++_sp & 255u) == 0u) { if (xb_ld(&(bar)[XB_TMO])) break; if (_sp > XB_SPIN_CAP) { atomicAdd(&(bar)[XB_TMO], 1u); break; } } } } while (0)

struct XcdBarrier {
    unsigned* bar; unsigned x;
    volatile LAS unsigned* st;
};

__device__ __forceinline__ XcdBarrier xcd_barrier_post(unsigned* bar, volatile LAS unsigned* st) {
    XcdBarrier b; b.bar = bar; b.x = xb_xcc_id(); b.st = st;
    if (threadIdx.x == 0) (void)xb_add(&bar[XB_XCNT(b.x)], 1u);
    return b;
}
__device__ __forceinline__ void xcd_barrier_complete(unsigned* bar, unsigned x, unsigned& nloc, unsigned& nx) {
    const unsigned G = gridDim.x * gridDim.y * gridDim.z;
    unsigned sum, cnt, mine, sp = 0u;
    for (;;) {
        sum = 0u; cnt = 0u; mine = 0u;
#pragma unroll
        for (unsigned j = 0; j < 16; ++j) { const unsigned c = xb_ld(&bar[XB_XCNT(j)]); sum += c; cnt += (c > 0u) ? 1u : 0u; mine = (j == x) ? c : mine; }
        if (sum == G) break;
        __builtin_amdgcn_s_sleep(1);
        if ((++sp & 255u) == 0u) { if (xb_ld(&bar[XB_TMO])) break; if (sp > XB_SPIN_CAP) { atomicAdd(&bar[XB_TMO], 1u); break; } }
    }
    nloc = mine > 0u ? mine : 1u; nx = cnt > 0u ? cnt : 1u;
}

__device__ __forceinline__ void xcd_barrier(const XcdBarrier& b) {
    asm volatile("s_waitcnt vmcnt(0)" ::: "memory");
    __syncthreads();
    if (threadIdx.x == 0) {
        unsigned* bar = b.bar;
        __builtin_amdgcn_s_waitcnt(0);
        unsigned nloc = b.st[0], nx = b.st[1];
        if (nloc == 0u) { xcd_barrier_complete(bar, b.x, nloc, nx); b.st[0] = nloc; b.st[1] = nx; }
        const unsigned old = xb_add(&bar[XB_XSUB(b.x)], 1u);
        const unsigned gen = old / nloc;
        if (old + 1u == (gen + 1u) * nloc) {
            __builtin_amdgcn_fence(__ATOMIC_RELEASE, "agent");
            asm volatile("s_waitcnt vmcnt(0)" ::: "memory");
            const unsigned og = xb_add(&bar[XB_TOP], 1u);
            const unsigned tg = og / nx;
            if (og + 1u == (tg + 1u) * nx) xb_add(&bar[XB_TOPGEN], 1u);
            else XB_SPIN(xb_ld(&bar[XB_TOPGEN]) == tg, bar);
            __builtin_amdgcn_fence(__ATOMIC_ACQUIRE, "agent");
            xb_add(&bar[XB_XGEN(b.x)], 1u);
            asm volatile("s_waitcnt vmcnt(0)" ::: "memory");
        } else {
            XB_SPIN(xb_ld(&bar[XB_XGEN(b.x)]) == gen, bar);
            __builtin_amdgcn_fence(__ATOMIC_ACQUIRE, "agent");
            asm volatile("s_waitcnt vmcnt(0)" ::: "memory");
        }
    }
    __syncthreads();
}


typedef float f32x4 __attribute__((ext_vector_type(4)));
typedef unsigned u32x4 __attribute__((ext_vector_type(4)));
typedef unsigned u32x2 __attribute__((ext_vector_type(2)));
typedef short bf16x8 __attribute__((ext_vector_type(8)));
typedef unsigned short bf16_t;
namespace {
constexpr int D_MODEL = 1024, BATCH = 8, SEQ = 2048, DEC_B = 32, DEC_T = 8, PAST = 16384, PAGE = 128, NPAGES = 128;
constexpr int NPROMPT = BATCH * SEQ, NSAMP = DEC_B * DEC_T, NTOK = NPROMPT + NSAMP;
constexpr int D_IN = 3352, NV = 3584;
constexpr int C_U = 0, C_V = 512, C_ZA = 1024, C_Q = 1536, C_KC = 2048, C_VC = 2176, C_KS = 2304, C_VS = 2432, C_KW = 2560, C_VW = 2688, C_G = 2816, C_ZB = 2840;
constexpr float EPS = 1e-6f, SCALE = 0.125f, NEGF = -1e30f, FORCEF = 1e9f;
constexpr size_t O_YP = 0, O_YS = 16777216, O_KVP = 17039360, O_WINP = 25427968, O_KVS = 26476544, O_WINS = 26607616, O_VS = 30801920;
constexpr int LDS_BYTES = 147456, MISC_OFF = 131072;
constexpr int NTHREADS = 512, NWAVES = 8;

struct Params {
    const float *x_prompt, *x_sample, *cache, *state_win; const int* page_table;
    const float *norm_g, *w_in, *ln_g, *ln_b, *w_s, *b_s, *cmp_pos, *w_cmp1, *b_cmp1, *w_cmp2, *w_out, *final_g;
    float* out;
    unsigned* ctl;
    bf16_t *XN, *WinT, *WoutT, *W1T, *W2T, *WSB, *U, *GV, *SZA, *Q, *QR, *KC, *VC, *KS, *VS, *KW, *VW, *SZB, *MRG;
    bf16_t *CKP, *CVTP, *CKS, *CVTS, *VSTT, *VWTT;
    float *VST, *SG, *ROPE, *CBP;
    float *P, *QR1, *mrg, *ypre, *hidp, *hids, *ckp, *cks;
    int lo, hi, li, pad;
};

__device__ __forceinline__ float bf2f(bf16_t v) { return __uint_as_float((unsigned)v << 16); }
__device__ __forceinline__ unsigned pk2(float lo, float hi) { return pg8::cvt_pk_bf16(lo, hi); }
__device__ __forceinline__ float fast_exp(float x) { return __builtin_amdgcn_exp2f(x * 1.4426950408889634f); }
__device__ __forceinline__ float fast_sigmoid(float x) { return __builtin_amdgcn_rcpf(1.0f + fast_exp(-x)); }
__device__ __forceinline__ float gelu_fast(float x) { const float u = 1.5957691216057308f * (x + 0.044715f * x * x * x); return x * fast_sigmoid(u); }
__device__ __forceinline__ float silu_fast(float x) { return x * fast_sigmoid(x); }
__device__ __forceinline__ float wave_sum(float v) {
#pragma unroll
    for (int o = 1; o < 64; o <<= 1) v += __shfl_xor(v, o);
    return v; }
__device__ __forceinline__ float wave_max(float v) {
#pragma unroll
    for (int o = 1; o < 64; o <<= 1) v = fmaxf(v, __shfl_xor(v, o));
    return v; }
__device__ __forceinline__ const float* xrow(const Params& p, int r) { return r < NPROMPT ? p.x_prompt + (size_t)r * D_MODEL : p.x_sample + (size_t)(r - NPROMPT) * D_MODEL; }

__device__ __forceinline__ int vgroup_actual(int vg) {
    const int tile = vg >> 3, gi = vg & 7, bj = gi >> 2, wc = gi & 3;
    if (tile < 2) return C_U + tile * 256 + gi * 32;
    if (tile < 4) return C_V + (tile - 2) * 256 + gi * 32;
    if (tile < 6) return C_ZA + (tile - 4) * 256 + gi * 32;
    if (tile < 8) return C_Q + (tile - 6) * 256 + wc * 64 + bj * 32;
    if (tile == 8) return C_KC + gi * 32;
    if (tile == 9) return (wc < 2 ? C_KS + wc * 64 : C_KW + (wc - 2) * 64) + bj * 32;
    if (tile == 10) return gi < 4 ? C_VS + gi * 32 : C_VW + (gi - 4) * 32;
    if (tile < 13) return C_ZB + (tile - 11) * 256 + gi * 32;
    return gi == 0 ? C_G : -1;
}

__device__ __forceinline__ void tr_item(const float* src, int ld_src, bf16_t* dst, int ld_dst, LAS float* scr, int lane) {
    if (src) {
#pragma unroll 8
        for (int i = 0; i < 32; ++i) { const int kk = 2 * i + (lane >> 5); scr[kk * 33 + (lane & 31)] = src[(size_t)kk * ld_src + (lane & 31)]; }
    }
    asm volatile("s_waitcnt lgkmcnt(0)" ::: "memory");
    const int c = lane & 7;
#pragma unroll
    for (int j = 0; j < 4; ++j) { const int n = (lane >> 3) + 8 * j; const LAS float* s = scr + (8 * c) * 33 + n;
        u32x4 o = (u32x4){0u, 0u, 0u, 0u};
        if (src) { o.x = pk2(s[0 * 33], s[1 * 33]); o.y = pk2(s[2 * 33], s[3 * 33]); o.z = pk2(s[4 * 33], s[5 * 33]); o.w = pk2(s[6 * 33], s[7 * 33]); }
        *(u32x4*)(dst + (size_t)n * ld_dst + 8 * c) = o; }
    asm volatile("s_waitcnt lgkmcnt(0)" ::: "memory");
}
__device__ __forceinline__ void rms_row_to_bf16(const float* xr_, const float* g, bf16_t* orow, int lane) {
    const f32x4* xr = (const f32x4*)xr_ + lane; const f32x4* gr = (const f32x4*)g + lane;
    f32x4 v[4]; float s = 0.f;
#pragma unroll
    for (int j = 0; j < 4; ++j) { v[j] = xr[64 * j]; s += (v[j].x * v[j].x + v[j].y * v[j].y) + (v[j].z * v[j].z + v[j].w * v[j].w); }
    const float rs = 1.0f / sqrtf(wave_sum(s) * (1.0f / D_MODEL) + EPS);
    unsigned long long* o8 = (unsigned long long*)orow + lane;
#pragma unroll
    for (int j = 0; j < 4; ++j) { const f32x4 gg = gr[64 * j];
        o8[64 * j] = (unsigned long long)pk2(v[j].x * rs * gg.x, v[j].y * rs * gg.y) | ((unsigned long long)pk2(v[j].z * rs * gg.z, v[j].w * rs * gg.w) << 32); }
}
__device__ __forceinline__ void p0_prologue(const Params& p, LAS unsigned char* lds) {
    const int tid = threadIdx.x, lane = tid & 63, wave = __builtin_amdgcn_readfirstlane(tid >> 6);
    const int G = gridDim.x, gw = blockIdx.x * NWAVES + wave, NGW = G * NWAVES, gt = blockIdx.x * NTHREADS + tid, NGT = G * NTHREADS;
    LAS float* scr = (LAS float*)(lds + wave * 16384);
    constexpr int I_IN = 16 * 112, I_OUT = 16 * 32, I_W1 = 2 * 32 * 4, I_W2 = 2 * 2 * 2, I_ALL = I_IN + I_OUT + I_W1 + I_W2;
    for (int it = gw; it < I_ALL; it += NGW) {
        int r = it;
        if (r < I_IN) { const int kb = r / 112, vg = r % 112, ac = vgroup_actual(vg);
            tr_item(ac >= 0 ? p.w_in + (size_t)(64 * kb) * D_IN + ac : nullptr, D_IN, p.WinT + (size_t)(32 * vg) * D_MODEL + 64 * kb, D_MODEL, scr, lane); continue; }
        r -= I_IN;
        if (r < I_OUT) { const int kb = r / 32, ng = r % 32; tr_item(p.w_out + (size_t)(64 * kb) * D_MODEL + 32 * ng, D_MODEL, p.WoutT + (size_t)(32 * ng) * D_MODEL + 64 * kb, D_MODEL, scr, lane); continue; }
        r -= I_OUT;
        if (r < I_W1) { const int kv = r / 128, kb = (r % 128) / 4, ng = r % 4;
            tr_item(p.w_cmp1 + ((size_t)kv * 2048 + 64 * kb) * 128 + 32 * ng, 128, p.W1T + ((size_t)kv * 128 + 32 * ng) * 2048 + 64 * kb, 2048, scr, lane); continue; }
        r -= I_W1;
        { const int kv = r / 4, kb = (r % 4) / 2, ng = r % 2;
            tr_item(p.w_cmp2 + ((size_t)kv * 128 + 64 * kb) * 64 + 32 * ng, 64, p.W2T + ((size_t)kv * 64 + 32 * ng) * 128 + 64 * kb, 128, scr, lane); }
    }
    for (int m = gw; m < NTOK; m += NGW) rms_row_to_bf16(xrow(p, m), p.norm_g, p.XN + (size_t)m * D_MODEL, lane);
    for (int idx = gt; idx < 2056 * 32; idx += NGT) {
        const int pi = idx >> 5, i = idx & 31; const double pos = pi < 2048 ? (double)pi : (double)(PAST + pi - 2048);
        double inv = 1.0; for (int k = 0; k < i; ++k) inv *= 0.7498942093324559;
        const double a = pos * inv, k = rint(a * 0.15915494309189535), r = fma(-k, 2.4492935982947064e-16, fma(-k, 6.283185307179586, a)), r2 = r * r;
        double sn = 1.0, cs = 1.0;
#pragma unroll
        for (int n = 13; n >= 1; --n) { sn = 1.0 - sn * r2 / (double)((2 * n) * (2 * n + 1)); cs = 1.0 - cs * r2 / (double)((2 * n - 1) * (2 * n)); }
        p.ROPE[2 * idx] = (float)cs; p.ROPE[2 * idx + 1] = (float)(sn * r);
    }
    for (int idx = gt; idx < DEC_B * 504 * 64; idx += NGT) { const int b = idx / (504 * 64), o4 = idx % (504 * 64);
        ((f32x4*)(p.out + O_WINS + (size_t)b * 512 * 256))[o4] = ((const f32x4*)(p.state_win + (size_t)b * 512 * 256 + 8 * 256))[o4]; }
    for (int idx = gt; idx < 8 * 128 * 128; idx += NGT) { const int t = (idx >> 7) & 127, s = idx & 127; p.WSB[idx] = s <= t ? (bf16_t)(pk2(p.w_s[idx], 0.f) & 0xffffu) : (bf16_t)0; }
    if (blockIdx.x < 32) {
        const int kv = blockIdx.x >> 4, part = blockIdx.x & 15, hid = tid & 127, sub = tid >> 7;
        float s = 0.f; const int x0 = part * 128 + sub * 32;
        for (int x = x0; x < x0 + 32; ++x) s += p.cmp_pos[kv * 2048 + x] * p.w_cmp1[((size_t)kv * 2048 + x) * 128 + hid];
        __syncthreads();
        LAS float* rd = (LAS float*)lds; rd[tid] = s; __syncthreads();
        if (tid < 128) p.CBP[(kv * 16 + part) * 128 + tid] = (rd[tid] + rd[128 + tid]) + (rd[256 + tid] + rd[384 + tid]);
        __syncthreads();
    }
}

struct EpiInProj {
    static constexpr bool PERM = true, AFTER_DRAIN = false;
    const Params& p;
    __device__ __forceinline__ static void st8(bf16_t* dst, const float (&v)[8]) { u32x4 w; w.x = pk2(v[0], v[1]); w.y = pk2(v[2], v[3]); w.z = pk2(v[4], v[5]); w.w = pk2(v[6], v[7]); *(u32x4*)dst = w; }
    __device__ __forceinline__ static void st8f(float* dst, const float (&v)[8]) { *(f32x4*)dst = (f32x4){v[0], v[1], v[2], v[3]}; *(f32x4*)(dst + 4) = (f32x4){v[4], v[5], v[6], v[7]}; }
    __device__ __forceinline__ static void get8(const f32x4 (&a)[2], float (&v)[8]) { v[0] = a[0][0]; v[1] = a[0][1]; v[2] = a[0][2]; v[3] = a[0][3]; v[4] = a[1][0]; v[5] = a[1][1]; v[6] = a[1][2]; v[7] = a[1][3]; }
    __device__ __forceinline__ void operator()(const f32x4 (&acc)[2][2][4][2], const pg8::Unit& u, int wr, int wc, int fr, int fq) const {
        const int tile = u.pn, c8 = 8 * fq;
#pragma unroll
        for (int ai = 0; ai < 2; ++ai)
#pragma unroll
            for (int m = 0; m < 4; ++m) {
                const int row = u.pm * 256 + ai * 128 + wr * 64 + m * 16 + fr;
                const bool samp = row >= NPROMPT; const int sr = row - NPROMPT;
                const int b = samp ? sr >> 3 : row >> 11, t = samp ? sr & 7 : row & 2047, pi = samp ? 2048 + t : t;
                float* outrow = samp ? p.out + O_KVS + (size_t)sr * 512 : p.out + O_KVP + (size_t)row * 512;
                float* winrow = samp ? p.out + O_WINS + ((size_t)b * 512 + 504 + t) * 256 : (t >= SEQ - 512 ? p.out + O_WINP + ((size_t)b * 512 + t - (SEQ - 512)) * 256 : nullptr);
                float v0[8], v1[8]; get8(acc[ai][0][m], v0); get8(acc[ai][1][m], v1);
                if (tile < 6 || tile == 11 || tile == 12) {
                    bf16_t* dst; int cb; bool is_gelu = tile < 4;
                    if (tile < 2) { dst = p.U; cb = tile * 256; } else if (tile < 4) { dst = p.GV; cb = (tile - 2) * 256; } else if (tile < 6) { dst = p.SZA; cb = (tile - 4) * 256; } else { dst = p.SZB; cb = (tile - 11) * 256; }
#pragma unroll
                    for (int e = 0; e < 8; ++e) { v0[e] = is_gelu ? gelu_fast(v0[e]) : silu_fast(v0[e]); v1[e] = is_gelu ? gelu_fast(v1[e]) : silu_fast(v1[e]); }
                    bf16_t* d = dst + (size_t)row * 512 + cb + 32 * wc + c8;
                    u32x4 w0, w1; w0.x = pk2(v0[0], v0[1]); w0.y = pk2(v0[2], v0[3]); w0.z = pk2(v0[4], v0[5]); w0.w = pk2(v0[6], v0[7]);
                    w1.x = pk2(v1[0], v1[1]); w1.y = pk2(v1[2], v1[3]); w1.z = pk2(v1[4], v1[5]); w1.w = pk2(v1[6], v1[7]);
                    *(u32x4*)d = w0; *(u32x4*)(d + 128) = w1;
                    if (tile == 2 || tile == 3) {
                        float s = 0.f, q = 0.f;
#pragma unroll
                        for (int k = 0; k < 4; ++k) { const unsigned a = w0[k], c = w1[k];
                            const float a0 = __uint_as_float(a << 16), a1 = __uint_as_float(a & 0xffff0000u), c0 = __uint_as_float(c << 16), c1 = __uint_as_float(c & 0xffff0000u);
                            s += (a0 + a1) + (c0 + c1); q += (a0 * a0 + a1 * a1) + (c0 * c0 + c1 * c1); }
                        s += __shfl_xor(s, 16); s += __shfl_xor(s, 32); q += __shfl_xor(q, 16); q += __shfl_xor(q, 32);
                        if (fq == 0) { float* st = p.VST + ((size_t)row * 8 + (tile - 2) * 4 + wc) * 2; st[0] = s; st[1] = q; }
                    }
                } else if (tile == 6 || tile == 7 || tile == 9) {
                    const float* rp = p.ROPE + ((size_t)pi * 32 + c8) * 2; float cs[16];
#pragma unroll
                    for (int k = 0; k < 4; ++k) { const f32x4 t4 = *(const f32x4*)(rp + 4 * k); cs[4 * k] = t4[0]; cs[4 * k + 1] = t4[1]; cs[4 * k + 2] = t4[2]; cs[4 * k + 3] = t4[3]; }
                    float r0[8], r1[8];
#pragma unroll
                    for (int e = 0; e < 8; ++e) { const float c = cs[2 * e], s = cs[2 * e + 1]; r0[e] = v0[e] * c - v1[e] * s; r1[e] = v1[e] * c + v0[e] * s; }
                    if (tile != 9) {
                        const int hh = (tile - 6) * 4 + wc; const size_t o = (size_t)row * 512 + hh * 64 + c8;
#pragma unroll
                        for (int e = 0; e < 8; ++e) { v0[e] *= SCALE; v1[e] *= SCALE; r0[e] *= SCALE; r1[e] *= SCALE; }
                        st8(p.Q + o, v0); st8(p.Q + o + 32, v1); st8(p.QR + o, r0); st8(p.QR + o + 32, r1);
                    } else if (wc < 2) {
                        const int h = wc; st8f(outrow + 256 + h * 64 + c8, r0); st8f(outrow + 256 + h * 64 + 32 + c8, r1);
                        st8(p.KS + (size_t)row * 128 + h * 64 + c8, r0); st8(p.KS + (size_t)row * 128 + h * 64 + 32 + c8, r1);
                    } else {
                        const int h = wc - 2; st8(p.KW + (size_t)row * 128 + h * 64 + c8, r0); st8(p.KW + (size_t)row * 128 + h * 64 + 32 + c8, r1);
                        if (winrow) { st8f(winrow + h * 64 + c8, r0); st8f(winrow + h * 64 + 32 + c8, r1); }
                    }
                } else if (tile == 8) {
                    st8f(outrow + 32 * wc + c8, v0); st8f(outrow + 128 + 32 * wc + c8, v1);
                    st8(p.KC + (size_t)row * 128 + 32 * wc + c8, v0); st8(p.VC + (size_t)row * 128 + 32 * wc + c8, v1);
                } else if (tile == 10) {
                    st8f(outrow + 384 + 32 * wc + c8, v0); st8(p.VS + (size_t)row * 128 + 32 * wc + c8, v0);
                    st8(p.VW + (size_t)row * 128 + 32 * wc + c8, v1); if (winrow) st8f(winrow + 128 + 32 * wc + c8, v1);
                    if (!samp) { const size_t to = ((size_t)(b * 2 + (wc >> 1)) * 64 + 32 * (wc & 1) + c8) * SEQ + t;
#pragma unroll
                        for (int e = 0; e < 8; ++e) { p.VSTT[to + (size_t)e * SEQ] = (bf16_t)(pk2(v0[e], 0.f) & 0xffffu); p.VWTT[to + (size_t)e * SEQ] = (bf16_t)(pk2(v1[e], 0.f) & 0xffffu); } }
                } else {
                    if (wc == 0 && fq < 3) {
#pragma unroll
                        for (int e = 0; e < 8; ++e) v0[e] = fast_sigmoid(v0[e]);
                        st8f(p.SG + (size_t)row * 24 + c8, v0);
                    }
                }
            }
    }
};

__device__ __forceinline__ void gmlp_unit(const Params& p, LAS unsigned char* lds, int unit) {
    int tid_ = threadIdx.x; asm volatile("" : "+v"(tid_));
    const int tid = tid_, lane = tid & 63, wave = tid >> 6, c = lane & 15, q = lane >> 4;
    const int ch = unit >> 3, g = unit & 7, r0 = ch * 128;
    LAS float* stat = (LAS float*)(lds + 32768); LAS bf16_t* VT = (LAS bf16_t*)lds;
    __syncthreads();
    if (tid < 128) { const float* st = p.VST + (size_t)(r0 + tid) * 16; float s = 0.f, qq = 0.f;
#pragma unroll
        for (int k = 0; k < 8; ++k) { s += st[2 * k]; qq += st[2 * k + 1]; }
        const float mu = s * (1.0f / 512.0f), var = fmaxf(qq * (1.0f / 512.0f) - mu * mu, 0.f); stat[2 * tid] = mu; stat[2 * tid + 1] = 1.0f / sqrtf(var + EPS); }
    __syncthreads();
    { const int tok = tid >> 2, cs = (tid & 3) * 16; const bf16_t* src = p.GV + (size_t)(r0 + tok) * 512 + g * 64 + cs;
      const u32x4 a = *(const u32x4*)src, b = *(const u32x4*)(src + 8); const float mu = stat[2 * tok], rs = stat[2 * tok + 1];
      const float* lg = p.ln_g + g * 64 + cs; const float* lb = p.ln_b + g * 64 + cs;
#pragma unroll
      for (int e = 0; e < 16; ++e) { const unsigned w = e < 8 ? a[e >> 1] : b[(e - 8) >> 1]; const float v = (e & 1) ? __uint_as_float(w & 0xffff0000u) : __uint_as_float(w << 16);
          const float vn = (v - mu) * rs * lg[e] + lb[e]; VT[(cs + e) * 136 + tok] = (bf16_t)(pk2(vn, 0.f) & 0xffffu); } }
    __syncthreads();
    f32x4 acc[4];
#pragma unroll
    for (int i = 0; i < 4; ++i) acc[i] = (f32x4){0.f, 0.f, 0.f, 0.f};
    const int nks = (wave >> 1) + 1; const bf16_t* wrow = p.WSB + ((size_t)g * 128 + wave * 16 + c) * 128 + 8 * q;
    for (int ks = 0; ks < nks; ++ks) {
        const bf16x8 wf = *(const bf16x8*)(wrow + 32 * ks);
#pragma unroll
        for (int dt = 0; dt < 4; ++dt) { const bf16x8 vf = *(const LAS bf16x8*)(VT + (dt * 16 + c) * 136 + 32 * ks + 8 * q);
            acc[dt] = __builtin_amdgcn_mfma_f32_16x16x32_bf16(vf, wf, acc[dt], 0, 0, 0); }
    }
    const int t = wave * 16 + c; const float bs = p.b_s[g * 128 + t]; const size_t ro = (size_t)(r0 + t) * 512 + g * 64, mo = (size_t)(r0 + t) * 1024 + g * 64;
#pragma unroll
    for (int dt = 0; dt < 4; ++dt) { const int d = dt * 16 + 4 * q; const u32x2 uu = *(const u32x2*)(p.U + ro + d), zz = *(const u32x2*)(p.SZA + ro + d);
        const float o0 = (acc[dt][0] + bs) * __uint_as_float(uu.x << 16) * __uint_as_float(zz.x << 16), o1 = (acc[dt][1] + bs) * __uint_as_float(uu.x & 0xffff0000u) * __uint_as_float(zz.x & 0xffff0000u);
        const float o2 = (acc[dt][2] + bs) * __uint_as_float(uu.y << 16) * __uint_as_float(zz.y << 16), o3 = (acc[dt][3] + bs) * __uint_as_float(uu.y & 0xffff0000u) * __uint_as_float(zz.y & 0xffff0000u);
        u32x2 w; w.x = pk2(o0, o1); w.y = pk2(o2, o3); *(u32x2*)(p.MRG + mo + d) = w; }
}
__device__ __forceinline__ void gmlp_sample_unit(const Params& p, int b) {
    int tid_ = threadIdx.x; asm volatile("" : "+v"(tid_));
    const int c = tid_, g = c >> 6; float vn[8];
#pragma unroll
    for (int t = 0; t < 8; ++t) { const int r = NPROMPT + b * 8 + t; const float* st = p.VST + (size_t)r * 16; float s = 0.f, qq = 0.f;
#pragma unroll
        for (int k = 0; k < 8; ++k) { s += st[2 * k]; qq += st[2 * k + 1]; }
        const float mu = s * (1.0f / 512.0f), var = fmaxf(qq * (1.0f / 512.0f) - mu * mu, 0.f), rs = 1.0f / sqrtf(var + EPS);
        vn[t] = (bf2f(p.GV[(size_t)r * 512 + c]) - mu) * rs * p.ln_g[c] + p.ln_b[c]; p.out[O_VS + (size_t)(b * 8 + t) * 512 + c] = vn[t]; }
#pragma unroll
    for (int t = 0; t < 8; ++t) { const int r = NPROMPT + b * 8 + t; const float* w = p.w_s + ((size_t)g * 128 + t) * 128; float m = p.b_s[g * 128 + t];
#pragma unroll
        for (int s = 0; s < 8; ++s) if (s <= t) m += w[s] * vn[s];
        p.MRG[(size_t)r * 1024 + c] = (bf16_t)(pk2(bf2f(p.U[(size_t)r * 512 + c]) * m * bf2f(p.SZA[(size_t)r * 512 + c]), 0.f) & 0xffffu); }
}
template <bool SAMPLE> __device__ __forceinline__ void compress_unit(const Params& p, LAS unsigned char* lds, int unit) {
    constexpr int BROW = 144;
    int tid_ = threadIdx.x; asm volatile("" : "+v"(tid_));
    const int tid = tid_, lane = tid & 63, wave = __builtin_amdgcn_readfirstlane(tid >> 6), c = lane & 15, q = lane >> 4;
    int b, kv, h, quarter = 0;
    if (SAMPLE) { quarter = unit & 3; h = (unit >> 2) & 1; kv = (unit >> 3) & 1; b = unit >> 4; } else { kv = unit & 1; b = unit >> 1; h = wave >> 2; }
    const int sq0 = SAMPLE ? 256 * quarter + 32 * wave : 32 * (wave & 3);
    LAS unsigned char* Bb = lds; LAS float* XB = (LAS float*)(lds + 73728); LAS float* FX = XB + 8 * 128; LAS float* RED = FX + 128; LAS float* CB = RED + 512;
    __syncthreads();
    if (tid < 128) { float s = p.b_cmp1[kv * 128 + tid];
#pragma unroll
        for (int k = 0; k < 16; ++k) s += p.CBP[(kv * 16 + k) * 128 + tid];
        CB[tid] = s; }
    const float* fbase[2]; const bf16_t* hbase[2];
#pragma unroll
    for (int st = 0; st < 2; ++st) { const int tok0 = 16 * (sq0 + 16 * st + c);
        if (SAMPLE) { const int phys = p.page_table[b * NPAGES + (tok0 >> 7)]; fbase[st] = p.cache + ((((size_t)phys * PAGE + (tok0 & 127)) * 4 + kv) * 2 + h) * 64 + 8 * q; hbase[st] = nullptr; }
        else { hbase[st] = (kv ? p.VC : p.KC) + (size_t)(b * SEQ + tok0) * 128 + h * 64 + 8 * q; fbase[st] = nullptr; } }
#define LOADA(ks_, f_) do { const int toff_ = (ks_) >> 1, dh_ = ((ks_) & 1) * 32; _Pragma("unroll") for (int st = 0; st < 2; ++st) { \
        if (SAMPLE) { const f32x4 a_ = *(const f32x4*)(fbase[st] + toff_ * 512 + dh_), b_ = *(const f32x4*)(fbase[st] + toff_ * 512 + dh_ + 4); \
            u32x4 w_; w_.x = pk2(a_.x, a_.y); w_.y = pk2(a_.z, a_.w); w_.z = pk2(b_.x, b_.y); w_.w = pk2(b_.z, b_.w); f_[st] = __builtin_bit_cast(bf16x8, w_); } \
        else f_[st] = *(const bf16x8*)(hbase[st] + toff_ * 128 + dh_); } } while (0)
    const int n0 = tid >> 3, wpart = tid & 7; const bf16_t* wsrc0 = p.W1T + ((size_t)kv * 128 + n0) * 2048 + wpart * 8; const int wdst0 = n0 * BROW + wpart * 16;
#define WSRC(j) (wsrc0 + ((j) & 1) * (64 * 2048) + ((j) >> 1) * 1024)
#define WDST(j) (wdst0 + (j) * (64 * BROW))
    u32x4 wreg[4];
#pragma unroll
    for (int j = 0; j < 4; ++j) wreg[j] = *(const u32x4*)(WSRC(j));
#pragma unroll
    for (int j = 0; j < 4; ++j) *(LAS u32x4*)(Bb + WDST(j)) = wreg[j];
    f32x4 acc[2][16];
#pragma unroll
    for (int st = 0; st < 2; ++st)
#pragma unroll
        for (int nt = 0; nt < 16; ++nt) acc[st][nt] = (f32x4){0.f, 0.f, 0.f, 0.f};
    bf16x8 af[2], an[2]; LOADA(0, af);
    __syncthreads();
    for (int s = 0; s < 16; ++s) {
        if (s < 15) {
#pragma unroll
            for (int j = 0; j < 4; ++j) wreg[j] = *(const u32x4*)(WSRC(j) + 64 * (s + 1)); }
        LAS unsigned char* buf = Bb + (s & 1) * (256 * BROW);
#pragma unroll
        for (int kk = 0; kk < 2; ++kk) { const int ks = 2 * s + kk;
            if (ks < 31) LOADA(ks + 1, an);
#pragma unroll
            for (int ng = 0; ng < 4; ++ng) {
                bf16x8 wf[4];
#pragma unroll
                for (int k = 0; k < 4; ++k) wf[k] = *(const LAS bf16x8*)(buf + (16 * (4 * ng + k) + c) * BROW + (kk * 32 + 8 * q) * 2);
#pragma unroll
                for (int k = 0; k < 4; ++k) { acc[0][4 * ng + k] = __builtin_amdgcn_mfma_f32_16x16x32_bf16(wf[k], af[0], acc[0][4 * ng + k], 0, 0, 0);
                    acc[1][4 * ng + k] = __builtin_amdgcn_mfma_f32_16x16x32_bf16(wf[k], af[1], acc[1][4 * ng + k], 0, 0, 0); }
                asm volatile("" ::: "memory");
            }
            af[0] = an[0]; af[1] = an[1]; }
        if (s < 15) { LAS unsigned char* nb = Bb + ((s + 1) & 1) * (256 * BROW);
#pragma unroll
            for (int j = 0; j < 4; ++j) *(LAS u32x4*)(nb + WDST(j)) = wreg[j]; }
        __syncthreads();
    }
#undef LOADA
#undef WSRC
#undef WDST
    if (c == 0) {
#pragma unroll
        for (int nt = 0; nt < 8; ++nt)
#pragma unroll
            for (int r = 0; r < 4; ++r) XB[wave * 128 + 16 * nt + 4 * q + r] = acc[0][8 + nt][r]; }
    if (SAMPLE && quarter < 3) {
        const int hid = tid & 127, part = tid >> 7, tok0 = 16 * (256 * (quarter + 1)); const int phys = p.page_table[b * NPAGES + (tok0 >> 7)];
        const float* sb = p.cache + ((((size_t)phys * PAGE + (tok0 & 127)) * 4 + kv) * 2 + h) * 64; const float* w1 = p.w_cmp1 + ((size_t)kv * 2048 + 1024) * 128 + hid; float s = 0.f;
        for (int x = part * 256; x < part * 256 + 256; ++x) s += sb[(x >> 6) * 512 + (x & 63)] * w1[(size_t)x * 128];
        RED[tid] = s; }
    __syncthreads();
    if (SAMPLE && quarter < 3 && tid < 128) FX[tid] = (RED[tid] + RED[128 + tid]) + (RED[256 + tid] + RED[384 + tid]);
    __syncthreads();
    const LAS float* nxt = (wave < 7) ? XB + (wave + 1) * 128 : FX;
    f32x4 o2[2][4];
#pragma unroll
    for (int st = 0; st < 2; ++st)
#pragma unroll
        for (int dt = 0; dt < 4; ++dt) o2[st][dt] = (f32x4){0.f, 0.f, 0.f, 0.f};
#pragma unroll
    for (int k2 = 0; k2 < 4; ++k2) {
        bf16x8 hf[2];
#pragma unroll
        for (int st = 0; st < 2; ++st) { float hv[8];
#pragma unroll
            for (int j = 0; j < 8; ++j) { const int nt = 2 * k2 + (j >> 2), r = j & 3, hid = 16 * nt + 4 * q + r;
                float sh = __shfl(acc[st][8 + nt][r], (lane + 1) & 63); const float bnd0 = __shfl(acc[1][8 + nt][r], (lane - 15) & 63);
                if (c == 15) sh = (st == 0) ? bnd0 : nxt[hid];
                hv[j] = gelu_fast(acc[st][nt][r] + sh + CB[hid]); }
            u32x4 w; w.x = pk2(hv[0], hv[1]); w.y = pk2(hv[2], hv[3]); w.z = pk2(hv[4], hv[5]); w.w = pk2(hv[6], hv[7]); hf[st] = __builtin_bit_cast(bf16x8, w); }
#pragma unroll
        for (int dt = 0; dt < 4; ++dt) { const bf16_t* w2 = p.W2T + ((size_t)kv * 64 + 16 * dt + c) * 128 + 32 * k2 + 4 * q;
            const u32x2 lo = *(const u32x2*)w2, hi = *(const u32x2*)(w2 + 16); u32x4 w; w.x = lo.x; w.y = lo.y; w.z = hi.x; w.w = hi.y; const bf16x8 wf = __builtin_bit_cast(bf16x8, w);
            o2[0][dt] = __builtin_amdgcn_mfma_f32_16x16x32_bf16(wf, hf[0], o2[0][dt], 0, 0, 0);
            o2[1][dt] = __builtin_amdgcn_mfma_f32_16x16x32_bf16(wf, hf[1], o2[1][dt], 0, 0, 0); }
    }
    constexpr int NK = SAMPLE ? 1024 : 128, NC = SAMPLE ? 1023 : 127; const int seq = b * 2 + h;
#pragma unroll
    for (int st = 0; st < 2; ++st) { const int i = sq0 + 16 * st + c; if (i < NC) {
#pragma unroll
        for (int dt = 0; dt < 4; ++dt) { const int d = 16 * dt + 4 * q;
            if (kv == 0) { u32x2 w; w.x = pk2(o2[st][dt][0], o2[st][dt][1]); w.y = pk2(o2[st][dt][2], o2[st][dt][3]); *(u32x2*)((SAMPLE ? p.CKS : p.CKP) + ((size_t)seq * NK + i) * 64 + d) = w; }
            else { bf16_t* vt = (SAMPLE ? p.CVTS : p.CVTP) + ((size_t)seq * 64 + d) * NK + i;
#pragma unroll
                for (int r = 0; r < 4; ++r) vt[(size_t)r * NK] = (bf16_t)(pk2(o2[st][dt][r], 0.f) & 0xffffu); } } } }
}
__device__ __forceinline__ void p2_phase(const Params& p, LAS unsigned char* lds) {
    for (int u = blockIdx.x; u < 1584; u += gridDim.x) {
        if (u < 512) compress_unit<true>(p, lds, u);
        else if (u < 528) compress_unit<false>(p, lds, u - 512);
        else if (u < 1552) gmlp_unit(p, lds, u - 528);
        else gmlp_sample_unit(p, u - 1552);
    }
}

typedef float f32x16 __attribute__((ext_vector_type(16)));
constexpr float LOG2E = 1.4426950408889634f;
constexpr int AT_KB = 0, AT_VB = 18432, AT_IMPW = 36864, AT_SC = 69632, AT_SELM = 77824, AT_UNION = 78080;
__device__ __forceinline__ int s_rowidx(int reg, int hf) { return (reg & 3) + 8 * (reg >> 2) + 4 * hf; }
struct KVSrc { const bf16_t* k; const bf16_t* v; int kstride, vstride; };
__device__ __forceinline__ void kv_load(const KVSrc& s, int key0, int tid, u32x4& kr, u32x4& vr) {
    const int r = tid >> 3, part = tid & 7;
    kr = *(const u32x4*)(s.k + (size_t)(key0 + r) * s.kstride + part * 8);
    vr = *(const u32x4*)(s.v + (size_t)r * s.vstride + key0 + part * 8);
}
__device__ __forceinline__ void kv_store(LAS unsigned char* lds, int buf, int tid, const u32x4& kr, const u32x4& vr) {
    const int r = tid >> 3, part = tid & 7;
    *(LAS u32x4*)(lds + AT_KB + buf * 9216 + r * 144 + part * 16) = kr;
    LAS u32x2* vd = (LAS u32x2*)(lds + AT_VB + buf * 8704 + r * 136 + part * 16); vd[0] = (u32x2){vr.x, vr.y}; vd[1] = (u32x2){vr.z, vr.w};
}
__device__ __forceinline__ void qk_block(LAS unsigned char* lds, int buf, const bf16x8 (&qf)[4], int lane, f32x16 (&S)[2]) {
    const int kr = lane & 31, hf = lane >> 5;
#pragma unroll
    for (int kt = 0; kt < 2; ++kt) {
        f32x16 a = {0.f, 0.f, 0.f, 0.f, 0.f, 0.f, 0.f, 0.f, 0.f, 0.f, 0.f, 0.f, 0.f, 0.f, 0.f, 0.f};
#pragma unroll
        for (int ks = 0; ks < 4; ++ks) { const bf16x8 kf = *(const LAS bf16x8*)(lds + AT_KB + buf * 9216 + (32 * kt + kr) * 144 + (16 * ks + 8 * hf) * 2);
            a = __builtin_amdgcn_mfma_f32_32x32x16_bf16(kf, qf[ks], a, 0, 0, 0); }
        S[kt] = a;
    }
}
__device__ __forceinline__ void pv_block(LAS unsigned char* lds, int buf, const f32x16 (&P)[2], int lane, f32x16 (&O)[2]) {
    const int dr = lane & 31, hf = lane >> 5;
#pragma unroll
    for (int s = 0; s < 4; ++s) {
        const f32x16& pp = P[s >> 1]; const int r0 = 8 * (s & 1);
        u32x4 pw; pw.x = pk2(pp[r0], pp[r0 + 1]); pw.y = pk2(pp[r0 + 2], pp[r0 + 3]); pw.z = pk2(pp[r0 + 4], pp[r0 + 5]); pw.w = pk2(pp[r0 + 6], pp[r0 + 7]);
        const bf16x8 pf = __builtin_bit_cast(bf16x8, pw);
#pragma unroll
        for (int dt = 0; dt < 2; ++dt) { const LAS unsigned char* vb = lds + AT_VB + buf * 8704 + (32 * dt + dr) * 136 + (16 * s + 4 * hf) * 2;
            const u32x2 lo = *(const LAS u32x2*)vb, hi = *(const LAS u32x2*)(vb + 16); u32x4 vw; vw.x = lo.x; vw.y = lo.y; vw.z = hi.x; vw.w = hi.y;
            O[dt] = __builtin_amdgcn_mfma_f32_32x32x16_bf16(__builtin_bit_cast(bf16x8, vw), pf, O[dt], 0, 0, 0); }
    }
}
template <class V> __device__ __forceinline__ void softmax_block(f32x16 (&S)[2], float& m, float& l, f32x16 (&O)[2], const V& valid) {
    float mx = NEGF;
#pragma unroll
    for (int kt = 0; kt < 2; ++kt)
#pragma unroll
        for (int r = 0; r < 16; ++r) { const float s = valid(kt, r) ? S[kt][r] : NEGF; S[kt][r] = s; mx = fmaxf(mx, s); }
    mx = fmaxf(mx, __shfl_xor(mx, 32));
    const float mn = fmaxf(m, mx), alpha = __builtin_amdgcn_exp2f((m - mn) * LOG2E), mb = mn * LOG2E; float ps = 0.f;
#pragma unroll
    for (int kt = 0; kt < 2; ++kt)
#pragma unroll
        for (int r = 0; r < 16; ++r) { const float pr = valid(kt, r) ? __builtin_amdgcn_exp2f(S[kt][r] * LOG2E - mb) : 0.f; S[kt][r] = pr; ps += pr; }
    ps += __shfl_xor(ps, 32);
    l = l * alpha + ps; m = mn;
#pragma unroll
    for (int dt = 0; dt < 2; ++dt) O[dt] = O[dt] * alpha;
}
__device__ __forceinline__ void attn_prompt_unit(const Params& p, LAS unsigned char* lds, int b, int h, int qt) {
    int tid_ = threadIdx.x; asm volatile("" : "+v"(tid_));
    const int tid = tid_, lane = tid & 63, wave = tid >> 6, g = wave >> 1, qh = wave & 1, hf = lane >> 5;
    const int ql = 32 * qh + (lane & 31), tq = qt * 64 + ql, row = b * SEQ + tq, hh = h * 4 + g, seq = b * 2 + h;
    LAS float* IMPW = (LAS float*)(lds + AT_IMPW); LAS float* SC = (LAS float*)(lds + AT_SC); LAS unsigned* SELM = (LAS unsigned*)(lds + AT_SELM); LAS unsigned* UNI = (LAS unsigned*)(lds + AT_UNION);
    __syncthreads();
    if (tid < 64) SELM[tid] = 0u; if (tid == 64) UNI[0] = 0u;
    bf16x8 qf[4];
#pragma unroll
    for (int ks = 0; ks < 4; ++ks) qf[ks] = *(const bf16x8*)(p.Q + (size_t)row * 512 + hh * 64 + 16 * ks + 8 * hf);
    { const KVSrc cs{p.CKP + (size_t)seq * 128 * 64, p.CVTP + (size_t)seq * 64 * 128, 64, 128}; u32x4 k0, v0, k1, v1; kv_load(cs, 0, tid, k0, v0); kv_load(cs, 64, tid, k1, v1);
      kv_store(lds, 0, tid, k0, v0); kv_store(lds, 1, tid, k1, v1); }
    __syncthreads();
    f32x16 out[2];
    {
        f32x16 S0[2], S1[2]; qk_block(lds, 0, qf, lane, S0); qk_block(lds, 1, qf, lane, S1);
        float mx = NEGF;
#pragma unroll
        for (int kt = 0; kt < 2; ++kt)
#pragma unroll
            for (int r = 0; r < 16; ++r) { const int i0 = 32 * kt + s_rowidx(r, hf), i1 = 64 + i0;
                const float a = (16 * i0 + 31 <= tq) ? S0[kt][r] : NEGF, c = (16 * i1 + 31 <= tq) ? S1[kt][r] : NEGF; S0[kt][r] = a; S1[kt][r] = c; mx = fmaxf(mx, fmaxf(a, c)); }
        mx = fmaxf(mx, __shfl_xor(mx, 32)); const float mb = mx * LOG2E; float ps = 0.f;
#pragma unroll
        for (int kt = 0; kt < 2; ++kt)
#pragma unroll
            for (int r = 0; r < 16; ++r) { const int i0 = 32 * kt + s_rowidx(r, hf), i1 = 64 + i0;
                const float a = (16 * i0 + 31 <= tq) ? __builtin_amdgcn_exp2f(S0[kt][r] * LOG2E - mb) : 0.f, c = (16 * i1 + 31 <= tq) ? __builtin_amdgcn_exp2f(S1[kt][r] * LOG2E - mb) : 0.f;
                S0[kt][r] = a; S1[kt][r] = c; ps += a + c; }
        ps += __shfl_xor(ps, 32); const float inv = 1.0f / fmaxf(ps, 1.0f);
#pragma unroll
        for (int kt = 0; kt < 2; ++kt) { S0[kt] = S0[kt] * inv; S1[kt] = S1[kt] * inv; }
        float prevx = 0.f;
#pragma unroll
        for (int tile = 0; tile < 4; ++tile) { const f32x16& T = (tile < 2) ? S0[tile & 1] : S1[tile & 1];
#pragma unroll
            for (int rq = 0; rq < 4; ++rq) { const float gs = (T[4 * rq] + T[4 * rq + 1]) + (T[4 * rq + 2] + T[4 * rq + 3]); const float x = __shfl_xor(T[4 * rq + 3], 32);
                const int J = 8 * tile + 2 * rq + hf; IMPW[(g * 64 + ql) * 32 + J] = gs + (hf ? x : prevx); prevx = x; } }
        out[0] = (f32x16){0.f, 0.f, 0.f, 0.f, 0.f, 0.f, 0.f, 0.f, 0.f, 0.f, 0.f, 0.f, 0.f, 0.f, 0.f, 0.f}; out[1] = out[0];
        pv_block(lds, 0, S0, lane, out); pv_block(lds, 1, S1, lane, out);
        const float g0 = p.SG[(size_t)row * 24 + hh * 3];
        out[0] = out[0] * g0; out[1] = out[1] * g0;
    }
    __syncthreads();
    {
        const int q = tid >> 3, sub = tid & 7;
        if (qt < 16) { if (sub == 0) SELM[q] = 0xffffffffu; if (tid == 0) UNI[0] = 0xffffffffu; }
        else {
#pragma unroll
            for (int e = 0; e < 4; ++e) { const int j = sub * 4 + e; const float im = (IMPW[(0 * 64 + q) * 32 + j] + IMPW[(1 * 64 + q) * 32 + j]) + (IMPW[(2 * 64 + q) * 32 + j] + IMPW[(3 * 64 + q) * 32 + j]);
                SC[q * 32 + j] = (j == 0 || j == qt || j == qt - 1) ? FORCEF : (j <= qt ? im : NEGF); }
        }
    }
    __syncthreads();
    if (qt >= 16) {
        const int q = tid >> 3, sub = tid & 7; unsigned bits = 0u;
#pragma unroll
        for (int e = 0; e < 4; ++e) { const int j = sub * 4 + e; const float sj = SC[q * 32 + j]; int rank = 0;
            for (int k = 0; k < 32; ++k) { const float sk = SC[q * 32 + k]; rank += (sk > sj || (sk == sj && k < j)) ? 1 : 0; }
            if (rank < 16) bits |= 1u << j; }
        atomicOr((unsigned*)(SELM + q), bits); atomicOr((unsigned*)UNI, bits);
    }
    __syncthreads();
    const unsigned selm = SELM[ql]; const unsigned uni = (unsigned)__builtin_amdgcn_readfirstlane((int)UNI[0]);
#pragma unroll
    for (int ks = 0; ks < 4; ++ks) qf[ks] = *(const bf16x8*)(p.QR + (size_t)row * 512 + hh * 64 + 16 * ks + 8 * hf);
    const float g1 = p.SG[(size_t)row * 24 + hh * 3 + 1], g2 = p.SG[(size_t)row * 24 + hh * 3 + 2];
#pragma unroll 1
    for (int br = 0; br < 2; ++br) {
        const KVSrc src = br == 0 ? KVSrc{p.KS + (size_t)b * SEQ * 128 + h * 64, p.VSTT + (size_t)seq * 64 * SEQ, 128, SEQ} : KVSrc{p.KW + (size_t)b * SEQ * 128 + h * 64, p.VWTT + (size_t)seq * 64 * SEQ, 128, SEQ};
        const int jlo = qt >= 8 ? qt - 8 : 0;
        unsigned blk = br == 0 ? (uni & (qt == 31 ? 0xffffffffu : ((2u << qt) - 1u))) : ((qt == 31 ? 0xffffffffu : ((2u << qt) - 1u)) & ~((1u << jlo) - 1u));
        f32x16 O[2]; O[0] = (f32x16){0.f, 0.f, 0.f, 0.f, 0.f, 0.f, 0.f, 0.f, 0.f, 0.f, 0.f, 0.f, 0.f, 0.f, 0.f, 0.f}; O[1] = O[0]; float m = NEGF, l = 0.f;
        int cur = 0; u32x4 kr, vr;
        { const int j0 = __builtin_ctz(blk); kv_load(src, 64 * j0, tid, kr, vr); kv_store(lds, 0, tid, kr, vr); }
        __syncthreads();
        while (blk) {
            const int j = __builtin_ctz(blk); blk &= blk - 1u;
            if (blk) kv_load(src, 64 * __builtin_ctz(blk), tid, kr, vr);
            f32x16 S[2]; qk_block(lds, cur, qf, lane, S);
            if (br == 0) {
                const bool lsel = (selm >> j) & 1u;
                if (j == qt) softmax_block(S, m, l, O, [&](int kt, int r) { return lsel && (32 * kt + s_rowidx(r, hf) <= ql); });
                else softmax_block(S, m, l, O, [&](int, int) { return lsel; });
            } else {
                if (j == qt) softmax_block(S, m, l, O, [&](int kt, int r) { return 32 * kt + s_rowidx(r, hf) <= ql; });
                else if (j == qt - 8) softmax_block(S, m, l, O, [&](int kt, int r) { return 32 * kt + s_rowidx(r, hf) > ql; });
                else softmax_block(S, m, l, O, [&](int, int) { return true; });
            }
            pv_block(lds, cur, S, lane, O);
            if (blk) kv_store(lds, cur ^ 1, tid, kr, vr);
            __syncthreads(); cur ^= 1;
        }
        const float sc = (br == 0 ? g1 : g2) / fmaxf(l, 1.0f);
        out[0] = out[0] + O[0] * sc; out[1] = out[1] + O[1] * sc;
    }
    const size_t ob = (size_t)row * 512 + hh * 64, mb2 = (size_t)row * 1024 + 512 + hh * 64;
#pragma unroll
    for (int dt = 0; dt < 2; ++dt)
#pragma unroll
        for (int rq = 0; rq < 4; ++rq) { const int d = 32 * dt + 8 * rq + 4 * hf; const u32x2 z = *(const u32x2*)(p.SZB + ob + d);
            u32x2 w; w.x = pk2(out[dt][4 * rq] * __uint_as_float(z.x << 16), out[dt][4 * rq + 1] * __uint_as_float(z.x & 0xffff0000u));
            w.y = pk2(out[dt][4 * rq + 2] * __uint_as_float(z.y << 16), out[dt][4 * rq + 3] * __uint_as_float(z.y & 0xffff0000u)); *(u32x2*)(p.MRG + mb2 + d) = w; }
}
__device__ __forceinline__ void p3_prompt(const Params& p, LAS unsigned char* lds) {
    for (int c = blockIdx.x; c < 256; c += gridDim.x) {
        const int vcu = (c & 7) * 32 + (c >> 3), bh = vcu >> 4, x = vcu & 15;
        attn_prompt_unit(p, lds, bh >> 1, bh & 1, 31 - x);
        attn_prompt_unit(p, lds, bh >> 1, bh & 1, x);
    }
}

struct SoftS { float m, l, o; };
__device__ __forceinline__ void tile_step_s(SoftS& st, const LAS float* Kt, const LAS float* Vt, const LAS float* q, LAS float* ps, bool valid, int lane) {
    float s = 0.f;
#pragma unroll 16
    for (int d = 0; d < 64; ++d) s += q[d] * Kt[lane * 65 + d];
    s = valid ? s : NEGF;
    const float mn = fmaxf(st.m, wave_max(s)), sc = __expf(st.m - mn), pr = valid ? __expf(s - mn) : 0.f;
    st.l = st.l * sc + wave_sum(pr); st.m = mn; ps[lane] = pr;
    __syncthreads();
    float o = st.o * sc;
#pragma unroll 16
    for (int k = 0; k < 64; ++k) o += ps[k] * Vt[k * 64 + lane];
    st.o = o;
    __syncthreads();
}
__device__ __forceinline__ void attn_sample_pair(const Params& p, LAS unsigned char* lds, int pairi) {
    int tid_ = threadIdx.x; asm volatile("" : "+v"(tid_));
    const int half = tid_ >> 8, tid = tid_ & 255, lane = tid & 63, g = tid >> 6, bid = pairi * 2 + half;
    const int t = bid & 7, h = (bid >> 3) & 1, b = bid >> 4, r = NPROMPT + b * DEC_T + t, tq = PAST + t, seq = b * 2 + h, hh = h * 4 + g;
    LAS unsigned char* L = lds + half * 57344;
    LAS float* sc = (LAS float*)L; LAS float* Kt = sc + 4 * 1024; LAS float* Vt = Kt + 64 * 65; LAS float* qs = Vt + 64 * 64; LAS float* qrs = qs + 256; LAS float* ps = qrs + 256; LAS float* score = ps + 256; LAS int* sel = (LAS int*)(score + 264);
    __syncthreads();
    qs[g * 64 + lane] = bf2f(p.Q[(size_t)r * 512 + hh * 64 + lane]); qrs[g * 64 + lane] = bf2f(p.QR[(size_t)r * 512 + hh * 64 + lane]);
    __syncthreads();
    const bf16_t* CK = p.CKS + (size_t)seq * 1024 * 64; const bf16_t* CVT = p.CVTS + (size_t)seq * 64 * 1024;
    float mx = NEGF;
    for (int i = lane; i < 1023; i += 64) { float s = 0.f; const u32x4* k4 = (const u32x4*)(CK + (size_t)i * 64);
#pragma unroll
        for (int c = 0; c < 8; ++c) { const u32x4 w = k4[c];
#pragma unroll
            for (int e = 0; e < 4; ++e) s += qs[g * 64 + c * 8 + 2 * e] * __uint_as_float(w[e] << 16) + qs[g * 64 + c * 8 + 2 * e + 1] * __uint_as_float(w[e] & 0xffff0000u); }
        s = (16 * i + 31 <= tq) ? s : NEGF; sc[g * 1024 + i] = s; mx = fmaxf(mx, s); }
    mx = wave_max(mx); float sum = 0.f;
    for (int i = lane; i < 1023; i += 64) { const float e = (16 * i + 31 <= tq) ? __expf(sc[g * 1024 + i] - mx) : 0.f; sc[g * 1024 + i] = e; sum += e; }
    sum = wave_sum(sum); const float inv = 1.0f / fmaxf(sum, 1.0f);
    for (int i = lane; i < 1024; i += 64) sc[g * 1024 + i] = i < 1023 ? sc[g * 1024 + i] * inv : 0.f;
    __syncthreads();
    float ocmp = 0.f;
    for (int i = 0; i < 1024; i += 8) { const u32x4 w = *(const u32x4*)(CVT + (size_t)lane * 1024 + i); const LAS float* pp = sc + g * 1024 + i;
#pragma unroll
        for (int e = 0; e < 4; ++e) ocmp += pp[2 * e] * __uint_as_float(w[e] << 16) + pp[2 * e + 1] * __uint_as_float(w[e] & 0xffff0000u); }
    const int tb = tq >> 6;
    for (int j = tid; j < 257; j += 256) { float im = 0.f; const int lo = max(0, 4 * j - 1), hi = min(1022, 4 * j + 3);
        for (int i = lo; i <= hi; ++i) im += (sc[i] + sc[1024 + i]) + (sc[2048 + i] + sc[3072 + i]);
        const bool forced = (j == 0) || (j == tb) || (j == tb - 1), valid = j * 64 <= tq; score[j] = forced ? FORCEF : (valid ? im : NEGF); }
    __syncthreads();
    for (int j = tid; j < 257; j += 256) { const float sj = score[j]; int rank = 0; for (int k = 0; k < 257; ++k) { const float sk = score[k]; rank += (sk > sj || (sk == sj && k < j)) ? 1 : 0; }
        if (rank < 16) sel[rank] = j; }
    __syncthreads();
    SoftS ss{NEGF, 0.f, 0.f}, sw{NEGF, 0.f, 0.f};
    for (int s = 0; s < 25; ++s) {
        const bool is_sel = s < 16; const int blk = is_sel ? sel[s] : s - 16;
        for (int idx = tid; idx < 64 * 16; idx += 256) { const int k = idx >> 4, d4 = (idx & 15) * 4, pos = blk * 64 + k; f32x4 kv, vv;
            const int lim = is_sel ? PAST : 512;
            if (pos < lim) { const float* kp = is_sel ? p.cache + ((((size_t)p.page_table[b * NPAGES + (pos >> 7)] * PAGE + (pos & 127)) * 4 + 2) * 2 + h) * 64 : p.state_win + ((((size_t)b * 512 + pos) * 2 + 0) * 2 + h) * 64;
                kv = *(const f32x4*)(kp + d4); vv = *(const f32x4*)(kp + 128 + d4); }
            else { const int ni = min(pos - lim, DEC_T - 1); const size_t o = (size_t)(NPROMPT + b * DEC_T + ni) * 128 + h * 64 + d4; const bf16_t* kb = is_sel ? p.KS : p.KW; const bf16_t* vb = is_sel ? p.VS : p.VW;
                const u32x2 a = *(const u32x2*)(kb + o), c = *(const u32x2*)(vb + o);
                kv = (f32x4){__uint_as_float(a.x << 16), __uint_as_float(a.x & 0xffff0000u), __uint_as_float(a.y << 16), __uint_as_float(a.y & 0xffff0000u)};
                vv = (f32x4){__uint_as_float(c.x << 16), __uint_as_float(c.x & 0xffff0000u), __uint_as_float(c.y << 16), __uint_as_float(c.y & 0xffff0000u)}; }
            Kt[k * 65 + d4] = kv.x; Kt[k * 65 + d4 + 1] = kv.y; Kt[k * 65 + d4 + 2] = kv.z; Kt[k * 65 + d4 + 3] = kv.w; *(LAS f32x4*)(Vt + k * 64 + d4) = vv; }
        __syncthreads();
        const int pos = blk * 64 + lane; bool valid;
        if (is_sel) valid = pos <= tq; else { const int kpos = PAST - 512 + pos, dist = tq - kpos; valid = pos < 520 && dist >= 0 && dist < 512; }
        if (is_sel) tile_step_s(ss, Kt, Vt, qrs + g * 64, ps + g * 64, valid, lane); else tile_step_s(sw, Kt, Vt, qrs + g * 64, ps + g * 64, valid, lane);
    }
    const float oslc = ss.o / fmaxf(ss.l, 1.0f), owin = sw.o / fmaxf(sw.l, 1.0f);
    const float g0 = p.SG[(size_t)r * 24 + hh * 3], g1 = p.SG[(size_t)r * 24 + hh * 3 + 1], g2 = p.SG[(size_t)r * 24 + hh * 3 + 2];
    p.MRG[(size_t)r * 1024 + 512 + hh * 64 + lane] = (bf16_t)(pk2((g0 * ocmp + g1 * oslc + g2 * owin) * bf2f(p.SZB[(size_t)r * 512 + hh * 64 + lane]), 0.f) & 0xffffu);
}
__device__ __forceinline__ void p3_phase(const Params& p, LAS unsigned char* lds) {
    for (int u = blockIdx.x; u < 256; u += gridDim.x) attn_sample_pair(p, lds, u);
    p3_prompt(p, lds);
}

struct EpiMerge {
    static constexpr bool PERM = true, AFTER_DRAIN = false;
    const Params& p;
    __device__ __forceinline__ void operator()(const f32x4 (&acc)[2][2][4][2], const pg8::Unit& u, int wr, int wc, int fr, int fq) const {
#pragma unroll
        for (int ai = 0; ai < 2; ++ai)
#pragma unroll
            for (int m = 0; m < 4; ++m) {
                const int row = u.pm * 256 + ai * 128 + wr * 64 + m * 16 + fr; const float* xr = xrow(p, row); float* yr = p.ypre + (size_t)row * D_MODEL;
#pragma unroll
                for (int bj = 0; bj < 2; ++bj) { const int col = u.pn * 256 + bj * 128 + 32 * wc + 8 * fq;
                    const f32x4 x0 = *(const f32x4*)(xr + col), x1 = *(const f32x4*)(xr + col + 4);
                    *(f32x4*)(yr + col) = x0 + acc[ai][bj][m][0]; *(f32x4*)(yr + col + 4) = x1 + acc[ai][bj][m][1]; }
                asm volatile("" ::: "memory");
            }
    }
};
__device__ __forceinline__ void p5_final(const Params& p) {
    const int lane = threadIdx.x & 63, wave = threadIdx.x >> 6, gw = blockIdx.x * NWAVES + wave, NGW = gridDim.x * NWAVES;
    for (int m = gw; m < NTOK; m += NGW) {
        const f32x4* xr = (const f32x4*)(p.ypre + (size_t)m * D_MODEL) + lane; const f32x4* gr = (const f32x4*)p.final_g + lane; f32x4* o = (f32x4*)(p.out + (size_t)m * D_MODEL) + lane;
        f32x4 v[4]; float s = 0.f;
#pragma unroll
        for (int j = 0; j < 4; ++j) { v[j] = xr[64 * j]; s += (v[j].x * v[j].x + v[j].y * v[j].y) + (v[j].z * v[j].z + v[j].w * v[j].w); }
        const float rs = 1.0f / sqrtf(wave_sum(s) * (1.0f / D_MODEL) + EPS);
#pragma unroll
        for (int j = 0; j < 4; ++j) o[64 * j] = v[j] * rs * gr[64 * j];
    }
}

__global__ void __launch_bounds__(NTHREADS, 2) fwd(Params p) {
    extern __shared__ __attribute__((aligned(16))) unsigned char lds_raw[];
    LAS unsigned char* lds = (LAS unsigned char*)lds_raw;
    const int tid = threadIdx.x;
    for (int u = tid; u < (LDS_BYTES - MISC_OFF) / 4; u += NTHREADS) ((LAS unsigned*)(lds + MISC_OFF))[u] = 0u;
    __syncthreads();
    XcdBarrier bar = xcd_barrier_post(p.ctl + 1024 + p.li * XCD_BAR_WORDS, (volatile LAS unsigned*)(lds + MISC_OFF));
    const int lo = p.lo, hi = p.hi;
#define IN(k) (lo <= (k) && (k) < hi)
#define BOTH(k) (IN(k) && IN((k) + 1))
    if (IN(0)) { p0_prologue(p, lds); if (BOTH(0)) xcd_barrier(bar); }
    if (IN(1)) {
        pg8::Gemm g{p.XN, p.WinT, NTOK, NV, D_MODEL}; pg8::StaticOrder S; S.init(NTOK, NV, gridDim.x, (int)blockIdx.x);
        EpiInProj E{p};
        pg8::gemm_phase<EpiInProj, pg8::StaticOrder, true, true>(lds, g, S, E);
        if (BOTH(1)) xcd_barrier(bar);
    }
    if (IN(2)) { p2_phase(p, lds); if (BOTH(2)) xcd_barrier(bar); }
    if (IN(3)) { p3_phase(p, lds); if (BOTH(3)) xcd_barrier(bar); }
    if (IN(4)) {
        pg8::Gemm g{p.MRG, p.WoutT, NTOK, D_MODEL, D_MODEL}; pg8::StaticOrder S; S.init(NTOK, D_MODEL, gridDim.x, (int)blockIdx.x);
        EpiMerge E{p};
        pg8::gemm_phase<EpiMerge, pg8::StaticOrder, true, true>(lds, g, S, E);
        if (BOTH(4)) xcd_barrier(bar);
    }
    if (IN(5)) p5_final(p);
#undef IN
#undef BOTH
}

__global__ __launch_bounds__(256) void k_conv(Params p) {
    const int r = blockIdx.x, t = threadIdx.x; float* P = p.P + (size_t)r * D_IN;
    for (int c = t; c < 512; c += 256) {
        P[C_U + c] = bf2f(p.U[(size_t)r * 512 + c]); P[C_ZA + c] = bf2f(p.SZA[(size_t)r * 512 + c]); P[C_ZB + c] = bf2f(p.SZB[(size_t)r * 512 + c]);
        P[C_Q + c] = bf2f(p.Q[(size_t)r * 512 + c]) * 8.0f; p.QR1[(size_t)r * 512 + c] = bf2f(p.QR[(size_t)r * 512 + c]) * 8.0f;
        float s = 0.f, q = 0.f; for (int k = 0; k < 8; ++k) { s += p.VST[((size_t)r * 8 + k) * 2]; q += p.VST[((size_t)r * 8 + k) * 2 + 1]; }
        const float mu = s * (1.0f / 512.0f), var = q * (1.0f / 512.0f) - mu * mu, rs = 1.0f / sqrtf(var + EPS);
        const float vn = (bf2f(p.GV[(size_t)r * 512 + c]) - mu) * rs * p.ln_g[c] + p.ln_b[c];
        P[C_V + c] = vn;
    }
    if (t < 128) { const size_t o = (size_t)r * 128 + t; P[C_KC + t] = bf2f(p.KC[o]); P[C_VC + t] = bf2f(p.VC[o]); P[C_KS + t] = bf2f(p.KS[o]); P[C_VS + t] = bf2f(p.VS[o]); P[C_KW + t] = bf2f(p.KW[o]); P[C_VW + t] = bf2f(p.VW[o]); }
    if (t < 24) P[C_G + t] = p.SG[(size_t)r * 24 + t];
}

__global__ __launch_bounds__(256) void k_conv3(Params p) {
    const size_t idx = (size_t)blockIdx.x * 256 + threadIdx.x; const int d = idx & 63; size_t rr = idx >> 6;
    if (rr < 2 * 2048) { const int kv = rr / 2048, row = rr % 2048, seq = row / 128, i = row % 128;
        p.ckp[rr * 64 + d] = kv == 0 ? bf2f(p.CKP[((size_t)seq * 128 + i) * 64 + d]) : bf2f(p.CVTP[((size_t)seq * 64 + d) * 128 + i]); return; }
    rr -= 2 * 2048; if (rr >= 2 * 65536) return;
    { const int kv = rr / 65536, row = rr % 65536, seq = row / 1024, i = row % 1024;
        p.cks[rr * 64 + d] = kv == 0 ? bf2f(p.CKS[((size_t)seq * 1024 + i) * 64 + d]) : bf2f(p.CVTS[((size_t)seq * 64 + d) * 1024 + i]); }
}
__global__ __launch_bounds__(256) void k_conv2(Params p) {
    const size_t e = (size_t)blockIdx.x * 256 + threadIdx.x; const size_t row = e >> 7, c4 = (e & 127) * 4; const size_t i = row * 1024 + 512 + c4; const f32x4 v = *(const f32x4*)(p.mrg + i);
    u32x2 w; w.x = pk2(v.x, v.y); w.y = pk2(v.z, v.w); *(u32x2*)(p.MRG + i) = w;
}

__device__ __forceinline__ float gelu_ref(float x) { const float u = 0.7978845608028654f * (x + 0.044715f * x * x * x); return 0.5f * x * (1.0f + tanhf(u)); }
template <class F> __global__ __launch_bounds__(256) void k_gemm(Params p, int M, int N, int K, F f) {
    __shared__ float As[16][132]; __shared__ float Bs[16][132];
    const int tid = threadIdx.x, lane = tid & 63, wid = tid >> 6, wm = wid >> 1, wn = wid & 1, z = blockIdx.z;
    const int m0 = blockIdx.y * 128, n0 = blockIdx.x * 128;
    f32x4 acc[4][4];
    for (int i = 0; i < 4; ++i) for (int j = 0; j < 4; ++j) acc[i][j] = (f32x4){0.f, 0.f, 0.f, 0.f};
    const int ar = tid >> 1, ak = (tid & 1) * 8, bk = tid >> 4, bn = (tid & 15) * 8;
    for (int k0 = 0; k0 < K; k0 += 16) {
        const float4 a0 = f.la(p, z, m0 + ar, k0 + ak), a1 = f.la(p, z, m0 + ar, k0 + ak + 4);
        const float4 b0 = f.lb(p, z, k0 + bk, n0 + bn, N), b1 = f.lb(p, z, k0 + bk, n0 + bn + 4, N);
        As[ak + 0][ar] = a0.x; As[ak + 1][ar] = a0.y; As[ak + 2][ar] = a0.z; As[ak + 3][ar] = a0.w;
        As[ak + 4][ar] = a1.x; As[ak + 5][ar] = a1.y; As[ak + 6][ar] = a1.z; As[ak + 7][ar] = a1.w;
        *(float4*)&Bs[bk][bn] = b0; *(float4*)&Bs[bk][bn + 4] = b1;
        __syncthreads();
#pragma unroll
        for (int ks = 0; ks < 16; ks += 4) {
            float a[4], b[4];
#pragma unroll
            for (int i = 0; i < 4; ++i) { a[i] = As[ks + (lane >> 4)][wm * 64 + i * 16 + (lane & 15)]; b[i] = Bs[ks + (lane >> 4)][wn * 64 + i * 16 + (lane & 15)]; }
#pragma unroll
            for (int i = 0; i < 4; ++i)
#pragma unroll
                for (int j = 0; j < 4; ++j) acc[i][j] = __builtin_amdgcn_mfma_f32_16x16x4f32(a[i], b[j], acc[i][j], 0, 0, 0);
        }
        __syncthreads();
    }
#pragma unroll
    for (int i = 0; i < 4; ++i)
#pragma unroll
      for (int j = 0; j < 4; ++j)
#pragma unroll
        for (int r = 0; r < 4; ++r) {
        const int row = m0 + wm * 64 + i * 16 + (lane >> 4) * 4 + r, col = n0 + wn * 64 + j * 16 + (lane & 15);
        if (row < M && col < N) f.ep(p, z, row, col, acc[i][j][r]);
    }
}
__device__ __forceinline__ float4 ld4(const float* q) { return *(const float4*)q; }
__device__ __forceinline__ float4 zero4() { return make_float4(0.f, 0.f, 0.f, 0.f); }
struct FMerge { int pad;
    __device__ float4 la(const Params& p, int, int r, int k) const { return ld4(p.mrg + (size_t)r * D_MODEL + k); }
    __device__ float4 lb(const Params& p, int, int k, int n, int) const { return ld4(p.w_out + (size_t)k * D_MODEL + n); }
    __device__ void ep(const Params& p, int, int r, int c, float v) const { p.ypre[(size_t)r * D_MODEL + c] = xrow(p, r)[c] + v; }
};
template <bool SAMPLE> struct FCmp { int pad;
    static constexpr int NB = SAMPLE ? 1024 : 128, NC = SAMPLE ? 1023 : 127;
    __device__ float4 la(const Params& p, int kv, int r, int x) const {
        const int seq = r / NB, i = r % NB, b = seq >> 1, h = seq & 1; if (i >= NC) return zero4();
        const int tok = 16 * i + (x >> 6), d = x & 63; float4 v;
        if (SAMPLE) { const int phys = p.page_table[b * NPAGES + (tok >> 7)], off = tok & 127; v = ld4(p.cache + ((((size_t)phys * PAGE + off) * 4 + kv) * 2 + h) * 64 + d); }
        else v = ld4(p.P + (size_t)(b * SEQ + tok) * D_IN + C_KC + kv * 128 + h * 64 + d);
        const float4 pe = ld4(p.cmp_pos + kv * 2048 + x); v.x += pe.x; v.y += pe.y; v.z += pe.z; v.w += pe.w; return v;
    }
    __device__ float4 lb(const Params& p, int kv, int k, int n, int) const { return ld4(p.w_cmp1 + ((size_t)kv * 2048 + k) * 128 + n); }
    __device__ void ep(const Params& p, int kv, int r, int c, float v) const {
        float* hid = SAMPLE ? p.hids : p.hidp; const int M = SAMPLE ? 65536 : 2048;
        hid[((size_t)kv * M + r) * 128 + c] = gelu_ref(v + p.b_cmp1[kv * 128 + c]);
    }
};
__global__ __launch_bounds__(256) void k_cmp2(Params p, int M, int sample) {
    const size_t idx = (size_t)blockIdx.x * 256 + threadIdx.x; const int d = idx & 63; const size_t rr = idx >> 6; if (rr >= (size_t)2 * M) return;
    const int kv = (int)(rr / M); const float* hid = (sample ? p.hids : p.hidp) + rr * 128; const float* w2 = p.w_cmp2 + (size_t)kv * 128 * 64 + d;
    float s = 0.f; for (int k = 0; k < 128; ++k) s += hid[k] * w2[k * 64];
    (sample ? p.cks : p.ckp)[rr * 64 + d] = s;
}
__global__ __launch_bounds__(256) void k_gmlp(Params p) {
    const int ch = blockIdx.x, g = blockIdx.y, tid = threadIdx.x; __shared__ float vn[128][64];
    const int r0 = ch < 128 ? ch * 128 : NPROMPT + (ch - 128) * DEC_T, T = ch < 128 ? 128 : DEC_T;
    for (int idx = tid; idx < T * 64; idx += 256) vn[idx >> 6][idx & 63] = p.P[(size_t)(r0 + (idx >> 6)) * D_IN + C_V + g * 64 + (idx & 63)];
    __syncthreads();
    for (int idx = tid; idx < T * 64; idx += 256) {
        const int t = idx >> 6, d = idx & 63; const float* w = p.w_s + ((size_t)g * 128 + t) * 128; float acc = 0.f;
        for (int s = 0; s <= t; ++s) acc += w[s] * vn[s][d];
        const float mixed = acc + p.b_s[g * 128 + t]; const float* P = p.P + (size_t)(r0 + t) * D_IN;
        p.mrg[(size_t)(r0 + t) * D_MODEL + g * 64 + d] = P[C_U + g * 64 + d] * mixed * P[C_ZA + g * 64 + d];
    }
}
struct Soft { float m, l, o; };
__device__ __forceinline__ void tile_step(Soft& st, const float (*Kt)[65], const float (*Vt)[64], const float* q, float* ps, bool valid, int lane) {
    float s = 0.f;
#pragma unroll 16
    for (int d = 0; d < 64; ++d) s += q[d] * Kt[lane][d];
    s = valid ? s * SCALE : NEGF;
    const float mn = fmaxf(st.m, wave_max(s)), sc = expf(st.m - mn), pr = valid ? expf(s - mn) : 0.f;
    st.l = st.l * sc + wave_sum(pr); st.m = mn; ps[lane] = pr;
    __syncthreads();
    float o = st.o * sc;
#pragma unroll 16
    for (int k = 0; k < 64; ++k) o += ps[k] * Vt[k][lane];
    st.o = o;
    __syncthreads();
}
template <bool SAMPLE> __global__ __launch_bounds__(256) void k_attn(Params p) {
    constexpr int NC = SAMPLE ? 1023 : 127, NCB = SAMPLE ? 1024 : 128, NS = SAMPLE ? 257 : 32, T = SAMPLE ? DEC_T : SEQ;
    __shared__ float sc[4][NCB]; __shared__ float Kt[64][65]; __shared__ float Vt[64][64]; __shared__ float qs[4][64], qrs[4][64], ps[4][64];
    __shared__ float score[NS + 3]; __shared__ int sel[16];
    const int tid = threadIdx.x, lane = tid & 63, g = tid >> 6;
    const int bid = blockIdx.x, t = bid % T, h = (bid / T) & 1, b = bid / (2 * T);
    const int r = SAMPLE ? NPROMPT + b * DEC_T + t : b * SEQ + t, tq = SAMPLE ? PAST + t : t, seq = b * 2 + h, hh = h * 4 + g;
    const float* Pr = p.P + (size_t)r * D_IN;
    qs[g][lane] = Pr[C_Q + hh * 64 + lane]; qrs[g][lane] = p.QR1[(size_t)r * 512 + hh * 64 + lane];
    __syncthreads();
    const float* CK = (SAMPLE ? p.cks : p.ckp) + (size_t)seq * NCB * 64; const float* CV = CK + (size_t)(SAMPLE ? 65536 : 2048) * 64;
    float mx = NEGF;
    for (int i = lane; i < NC; i += 64) { float s = 0.f; const float* k = CK + (size_t)i * 64; for (int d = 0; d < 64; ++d) s += qs[g][d] * k[d];
        s = (16 * i + 31 <= tq) ? s * SCALE : NEGF; sc[g][i] = s; mx = fmaxf(mx, s); }
    mx = wave_max(mx); float sum = 0.f;
    for (int i = lane; i < NC; i += 64) { const float e = (16 * i + 31 <= tq) ? expf(sc[g][i] - mx) : 0.f; sc[g][i] = e; sum += e; }
    sum = wave_sum(sum); const float inv = 1.0f / fmaxf(sum, 1.0f);
    for (int i = lane; i < NC; i += 64) sc[g][i] *= inv;
    __syncthreads();
    float ocmp = 0.f; for (int i = 0; i < NC; ++i) ocmp += sc[g][i] * CV[(size_t)i * 64 + lane];
    __syncthreads();
    const int tb = tq >> 6;
    for (int j = tid; j < NS; j += 256) { float im = 0.f; const int lo = max(0, 4 * j - 1), hi = min(NC - 1, 4 * j + 3);
        for (int i = lo; i <= hi; ++i) im += (sc[0][i] + sc[1][i]) + (sc[2][i] + sc[3][i]);
        const bool forced = (j == 0) || (j == tb) || (j == tb - 1), valid = j * 64 <= tq; score[j] = forced ? FORCEF : (valid ? im : NEGF); }
    __syncthreads();
    for (int j = tid; j < NS; j += 256) { const float sj = score[j]; int rank = 0; for (int k = 0; k < NS; ++k) { const float sk = score[k]; rank += (sk > sj || (sk == sj && k < j)) ? 1 : 0; }
        if (rank < 16) sel[rank] = j; }
    __syncthreads();
    Soft ss{NEGF, 0.f, 0.f};
    for (int s = 0; s < 16; ++s) {
        const int blk = sel[s];
        for (int idx = tid; idx < 64 * 16; idx += 256) { const int k = idx >> 4, d4 = (idx & 15) * 4, pos = blk * 64 + k; const float *kp, *vp;
            if (SAMPLE) { if (pos < PAST) { const int phys = p.page_table[b * NPAGES + (pos >> 7)], off = pos & 127; kp = p.cache + ((((size_t)phys * PAGE + off) * 4 + 2) * 2 + h) * 64; vp = kp + 128; }
                          else { const int ni = min(pos - PAST, DEC_T - 1); kp = p.P + (size_t)(NPROMPT + b * DEC_T + ni) * D_IN + C_KS + h * 64; vp = kp + 128; } }
            else { kp = p.P + (size_t)(b * SEQ + pos) * D_IN + C_KS + h * 64; vp = kp + 128; }
            const float4 kv = ld4(kp + d4), vv = ld4(vp + d4); Kt[k][d4] = kv.x; Kt[k][d4 + 1] = kv.y; Kt[k][d4 + 2] = kv.z; Kt[k][d4 + 3] = kv.w; *(float4*)&Vt[k][d4] = vv; }
        __syncthreads();
        tile_step(ss, Kt, Vt, qrs[g], ps[g], blk * 64 + lane <= tq, lane);
        __syncthreads();
    }
    const float oslc = ss.o / fmaxf(ss.l, 1.0f);
    Soft sw{NEGF, 0.f, 0.f};
    const int c_lo = SAMPLE ? 0 : max(0, tq - 511) >> 6, c_hi = SAMPLE ? 8 : tq >> 6;
    for (int c = c_lo; c <= c_hi; ++c) {
        for (int idx = tid; idx < 64 * 16; idx += 256) { const int k = idx >> 4, d4 = (idx & 15) * 4, pos = c * 64 + k; const float *kp, *vp;
            if (SAMPLE) { if (pos < 512) { kp = p.state_win + ((((size_t)b * 512 + pos) * 2 + 0) * 2 + h) * 64; vp = kp + 128; }
                          else { const int ni = min(pos - 512, DEC_T - 1); kp = p.P + (size_t)(NPROMPT + b * DEC_T + ni) * D_IN + C_KW + h * 64; vp = kp + 128; } }
            else { kp = p.P + (size_t)(b * SEQ + pos) * D_IN + C_KW + h * 64; vp = kp + 128; }
            const float4 kv = ld4(kp + d4), vv = ld4(vp + d4); Kt[k][d4] = kv.x; Kt[k][d4 + 1] = kv.y; Kt[k][d4 + 2] = kv.z; Kt[k][d4 + 3] = kv.w; *(float4*)&Vt[k][d4] = vv; }
        __syncthreads();
        const int idx = c * 64 + lane; bool valid;
        if (SAMPLE) { const int kpos = PAST - 512 + idx, dist = tq - kpos; valid = idx < 520 && dist >= 0 && dist < 512; }
        else { const int dist = tq - idx; valid = dist >= 0 && dist < 512; }
        tile_step(sw, Kt, Vt, qrs[g], ps[g], valid, lane);
        __syncthreads();
    }
    const float owin = sw.o / fmaxf(sw.l, 1.0f);
    const float g0 = Pr[C_G + hh * 3], g1 = Pr[C_G + hh * 3 + 1], g2 = Pr[C_G + hh * 3 + 2];
    p.mrg[(size_t)r * D_MODEL + 512 + hh * 64 + lane] = (g0 * ocmp + g1 * oslc + g2 * owin) * Pr[C_ZB + hh * 64 + lane];
}
__global__ __launch_bounds__(256) void k_final(Params p) {
    const int r = blockIdx.x, t = threadIdx.x; __shared__ float red[4];
    const float4 v = *(const float4*)(p.ypre + (size_t)r * D_MODEL + t * 4);
    float s = wave_sum(v.x * v.x + v.y * v.y + v.z * v.z + v.w * v.w);
    if ((t & 63) == 0) red[t >> 6] = s; __syncthreads();
    s = red[0] + red[1] + red[2] + red[3];
    const float rs = 1.0f / sqrtf(s * (1.0f / D_MODEL) + EPS); const float4 g = *(const float4*)(p.final_g + t * 4);
    float4 o; o.x = v.x * rs * g.x; o.y = v.y * rs * g.y; o.z = v.z * rs * g.z; o.w = v.w * rs * g.w;
    *(float4*)(p.out + (size_t)r * D_MODEL + t * 4) = o;
}
}

extern "C" void kernel_launch(void* const* d_in, const int* in_sizes, int n_in, void* d_out, int out_size, void* d_ws, size_t ws_size, hipStream_t stream) {
    static int grid = 0;
    if (grid == 0) {
        int dev = 0, cus = 0, per_cu = 0;
        hipGetDevice(&dev); hipDeviceGetAttribute(&cus, hipDeviceAttributeMultiprocessorCount, dev);
        if (hipFuncSetAttribute((const void*)fwd, hipFuncAttributeMaxDynamicSharedMemorySize, LDS_BYTES) != hipSuccess) fprintf(stderr, "hipFuncSetAttribute failed\n");
        if (hipOccupancyMaxActiveBlocksPerMultiprocessor(&per_cu, (const void*)fwd, NTHREADS, LDS_BYTES) != hipSuccess || per_cu < 1) fprintf(stderr, "occupancy query: %d\n", per_cu);
        (void)hipGetLastError();
        grid = cus > 0 ? cus : 256;
    }
    Params p{};
    p.x_prompt = (const float*)d_in[0]; p.x_sample = (const float*)d_in[1]; p.cache = (const float*)d_in[2]; p.state_win = (const float*)d_in[3]; p.page_table = (const int*)d_in[4];
    p.norm_g = (const float*)d_in[5]; p.w_in = (const float*)d_in[6]; p.ln_g = (const float*)d_in[7]; p.ln_b = (const float*)d_in[8]; p.w_s = (const float*)d_in[9]; p.b_s = (const float*)d_in[10];
    p.cmp_pos = (const float*)d_in[11]; p.w_cmp1 = (const float*)d_in[12]; p.b_cmp1 = (const float*)d_in[13]; p.w_cmp2 = (const float*)d_in[14]; p.w_out = (const float*)d_in[15]; p.final_g = (const float*)d_in[16];
    p.out = (float*)d_out;
    unsigned char* w = (unsigned char*)d_ws; size_t o = 0;
    auto take = [&](size_t bytes) { unsigned char* r = w + o; o += (bytes + 255) & ~(size_t)255; return r; };
    p.ctl = (unsigned*)take(1 << 20);
    p.XN = (bf16_t*)take((size_t)NTOK * 1024 * 2); p.WinT = (bf16_t*)take((size_t)NV * 1024 * 2); p.WoutT = (bf16_t*)take((size_t)1024 * 1024 * 2);
    p.W1T = (bf16_t*)take((size_t)2 * 128 * 2048 * 2); p.W2T = (bf16_t*)take((size_t)2 * 64 * 128 * 2); p.WSB = (bf16_t*)take((size_t)8 * 128 * 128 * 2);
    p.U = (bf16_t*)take((size_t)NTOK * 512 * 2); p.GV = (bf16_t*)take((size_t)NTOK * 512 * 2); p.SZA = (bf16_t*)take((size_t)NTOK * 512 * 2); p.Q = (bf16_t*)take((size_t)NTOK * 512 * 2);
    p.QR = (bf16_t*)take((size_t)NTOK * 512 * 2); p.SZB = (bf16_t*)take((size_t)NTOK * 512 * 2); p.MRG = (bf16_t*)take((size_t)NTOK * 1024 * 2);
    p.KC = (bf16_t*)take((size_t)NTOK * 128 * 2); p.VC = (bf16_t*)take((size_t)NTOK * 128 * 2); p.KS = (bf16_t*)take((size_t)NTOK * 128 * 2); p.VS = (bf16_t*)take((size_t)NTOK * 128 * 2);
    p.KW = (bf16_t*)take((size_t)NTOK * 128 * 2); p.VW = (bf16_t*)take((size_t)NTOK * 128 * 2);
    p.CKP = (bf16_t*)take((size_t)16 * 128 * 64 * 2); p.CVTP = (bf16_t*)take((size_t)16 * 128 * 64 * 2); p.CKS = (bf16_t*)take((size_t)64 * 1024 * 64 * 2); p.CVTS = (bf16_t*)take((size_t)64 * 1024 * 64 * 2);
    p.VSTT = (bf16_t*)take((size_t)16 * 64 * SEQ * 2); p.VWTT = (bf16_t*)take((size_t)16 * 64 * SEQ * 2);
    p.VST = (float*)take((size_t)NTOK * 16 * 4); p.SG = (float*)take((size_t)NTOK * 24 * 4); p.ROPE = (float*)take((size_t)2056 * 64 * 4); p.CBP = (float*)take((size_t)2 * 16 * 128 * 4);
    p.P = (float*)take((size_t)NTOK * D_IN * 4); p.QR1 = (float*)take((size_t)NTOK * 512 * 4); p.mrg = (float*)take((size_t)NTOK * 1024 * 4); p.ypre = (float*)take((size_t)NTOK * 1024 * 4);
    p.hidp = (float*)take((size_t)2 * 2048 * 128 * 4); p.hids = (float*)take((size_t)2 * 65536 * 128 * 4); p.ckp = (float*)take((size_t)2 * 2048 * 64 * 4); p.cks = (float*)take((size_t)2 * 65536 * 64 * 4);
    hipMemsetAsync(p.ctl, 0, 1 << 20, stream);
    p.lo = 0; p.hi = 6; p.li = 0; p.pad = 0;
    hipLaunchKernelGGL(fwd, dim3(grid), dim3(NTHREADS), LDS_BYTES, stream, p);
}
```

```cpp
#include <hip/hip_runtime.h>
#include <stdint.h>
#include <cstdio>

namespace pg8 {
#define PG8_LAS __attribute__((address_space(3)))
typedef unsigned short bf16_t;
typedef short bf16x8 __attribute__((ext_vector_type(8)));
typedef float f32x4 __attribute__((ext_vector_type(4)));
typedef unsigned u32x4 __attribute__((ext_vector_type(4)));
constexpr int BM = 256, BK = 64, HALF = 128, HTB = HALF * BK * 2  , STAGE_BYTES = 8 * HTB, NXCD = 8, WGM = 8;

__host__ __device__ __forceinline__ int lds_byte(int r, int c) { const int st = (r >> 4) * 2 + (c >> 5), rr = r & 15, cc = c & 31, ob = rr * 64 + cc * 2; return st * 1024 + (ob ^ (((ob >> 9) & 1) << 5)); }
__host__ __device__ __forceinline__ void stage_rc(int b, int& R, int& C) { const int st = b / 1024, sb = b % 1024, swz = sb ^ (((sb >> 9) & 1) << 5); R = (st >> 1) * 16 + swz / 64; C = (st & 1) * 32 + (swz % 64) / 2; }
__host__ __device__ __forceinline__ int perm32(int rho) { const int n = rho >> 4, i = rho & 15; return 8 * (i >> 2) + 4 * n + (i & 3); }

struct Unit { int pm, pn; };
struct Gemm { const bf16_t* A; const bf16_t* Bt; int M, N, K; };

struct StaticOrder {
    int nM, nN, nwg, G, c;
    __host__ __device__ void init(int M, int N, int G_, int c_) { nM = M / BM; nN = N / BM; nwg = nM * nN; G = G_; c = c_; }
    __host__ __device__ bool next(int i, Unit& u) const {
        const long L = (long)i * G + c; if (L >= nwg) return false;
        int wgid = (int)L; { const int q = nwg / NXCD, r = nwg % NXCD, xcd = wgid % NXCD, off = wgid / NXCD; wgid = (xcd < r ? xcd * (q + 1) : r * (q + 1) + (xcd - r) * q) + off; }
        const int nig = WGM * nN, gid = wgid / nig, fm = gid * WGM, gsz = (nM - fm) < WGM ? (nM - fm) : WGM;
        u.pm = fm + ((wgid % nig) % gsz); u.pn = (wgid % nig) / gsz; return true;
    }
    __device__ __forceinline__ void a_ready(const Unit&) const {}
    __device__ __forceinline__ void done(const Unit&) const {}
};

__device__ __forceinline__ unsigned cvt_pk_bf16(float lo, float hi) { unsigned r; asm volatile("v_cvt_pk_bf16_f32 %0, %1, %2" : "=v"(r) : "v"(lo), "v"(hi)); return r; }
template <class Epi, class Sched, bool ALIGN_EPI = false, bool SP2 = false>
__device__ __forceinline__ void gemm_phase(PG8_LAS unsigned char* lds, const Gemm g, const Sched& S, const Epi& E) {
    const int tid = threadIdx.x, wid = __builtin_amdgcn_readfirstlane(tid >> 6), lane = tid & 63, wr = wid >> 2, wc = wid & 3, fr = lane & 15, fq = lane >> 4;
    const int K = g.K, nt = K / BK;
    unsigned voffA[2], voffB[2];
#pragma unroll
    for (int i = 0; i < 2; ++i) { int R, C; stage_rc(tid * 16 + i * 8192, R, C); const int Rb = Epi::PERM ? ((R & ~31) + perm32(R & 31)) : R;
        voffA[i] = (unsigned)(R * K + C) * 2u; voffB[i] = (unsigned)(Rb * K + C) * 2u; }
    const size_t kstep = (size_t)(BK * 2);
    const size_t hstep = (size_t)HALF * K * 2;
    const size_t tstep = 2 * hstep;
    const unsigned ldsw = (unsigned)wid * 1024u;
    const int aoff = lds_byte(wr * 64 + fr, fq * 8), boff = lds_byte(wc * 32 + fr, fq * 8);
#define PG8_SA(b, h) (((b) * 2 + (h)) * HTB)
#define PG8_SB(b, h) ((4 + (b) * 2 + (h)) * HTB)
#define PG8_STAGE(bufoff, gbase, voff) do { _Pragma("unroll") for (int _i = 0; _i < 2; ++_i) \
        __builtin_amdgcn_global_load_lds((const unsigned*)((const char*)(gbase) + (voff)[_i]), (PG8_LAS unsigned*)(lds + (bufoff) + ldsw + _i * 8192), 16, 0, 0); } while (0)
#define PG8_LDA(dst, b, h) do { _Pragma("unroll") for (int m = 0; m < 4; ++m) _Pragma("unroll") for (int k = 0; k < 2; ++k) dst[m][k] = *(const PG8_LAS bf16x8*)(lds + PG8_SA(b, h) + aoff + m * 2048 + k * 1024); } while (0)
#define PG8_LDB(dst, b, h) do { _Pragma("unroll") for (int n = 0; n < 2; ++n) _Pragma("unroll") for (int k = 0; k < 2; ++k) dst[n][k] = *(const PG8_LAS bf16x8*)(lds + PG8_SB(b, h) + boff + n * 2048 + k * 1024); } while (0)
#define PG8_MMA(ai, bj, At, Bt) do { __builtin_amdgcn_s_setprio(1); _Pragma("unroll") for (int m = 0; m < 4; ++m) _Pragma("unroll") for (int n = 0; n < 2; ++n) _Pragma("unroll") for (int k = 0; k < 2; ++k) \
        acc[ai][bj][m][n] = __builtin_amdgcn_mfma_f32_16x16x32_bf16(Bt[n][k], At[m][k], acc[ai][bj][m][n], 0, 0, 0); __builtin_amdgcn_s_setprio(0); } while (0)
#define PG8_WAIT_V(n) asm volatile("s_waitcnt vmcnt(" #n ")" ::: "memory")
#define PG8_WAIT_L(n) asm volatile("s_waitcnt lgkmcnt(" #n ")" ::: "memory")
#define PG8_BAR __builtin_amdgcn_s_barrier()
#define PG8_SCHED __builtin_amdgcn_sched_barrier(0)
    Unit cur, nxt; int ui = 0;
    if (!S.next(0, cur)) return;
    f32x4 acc[2][2][4][2];
#pragma unroll
    for (int a = 0; a < 2; ++a)
#pragma unroll
        for (int b = 0; b < 2; ++b)
#pragma unroll
            for (int m = 0; m < 4; ++m)
#pragma unroll
                for (int n = 0; n < 2; ++n) acc[a][b][m][n] = (f32x4){0.f, 0.f, 0.f, 0.f};
    bf16x8 At[4][2], B0[2][2], B1[2][2];
    const char* cA = (const char*)g.A + (size_t)cur.pm * tstep; const char* cB = (const char*)g.Bt + (size_t)cur.pn * tstep;
    S.a_ready(cur);
    if constexpr (SP2) {
        PG8_STAGE(PG8_SB(0, 0), cB, voffB); PG8_STAGE(PG8_SB(0, 1), cB + hstep, voffB); PG8_STAGE(PG8_SA(0, 0), cA, voffA); PG8_STAGE(PG8_SA(0, 1), cA + hstep, voffA);
        if (wr == 1) PG8_BAR;
        PG8_WAIT_V(2); PG8_BAR;
        PG8_STAGE(PG8_SB(1, 0), cB + kstep, voffB); PG8_STAGE(PG8_SA(1, 0), cA + kstep, voffA); PG8_STAGE(PG8_SB(1, 1), cB + hstep + kstep, voffB);
        PG8_WAIT_V(6); PG8_BAR;
    } else {
        PG8_STAGE(PG8_SB(0, 0), cB, voffB); PG8_STAGE(PG8_SA(0, 0), cA, voffA); PG8_STAGE(PG8_SB(0, 1), cB + hstep, voffB); PG8_STAGE(PG8_SA(0, 1), cA + hstep, voffA);
        if (wr == 1) PG8_BAR;
        PG8_WAIT_V(4); PG8_BAR;
        PG8_STAGE(PG8_SB(1, 0), cB + kstep, voffB); PG8_STAGE(PG8_SA(1, 0), cA + kstep, voffA); PG8_STAGE(PG8_SB(1, 1), cB + hstep + kstep, voffB);
        PG8_WAIT_V(6); PG8_BAR;
    }
    for (;;) {
        const bool has_next = S.next(ui + 1, nxt);
        const char* nA = has_next ? (const char*)g.A + (size_t)nxt.pm * tstep : cA; const char* nB = has_next ? (const char*)g.Bt + (size_t)nxt.pn * tstep : cB;
        for (int t = 0; t < nt; t += 2) {
            const bool last = (t == nt - 2);
            const char* a1 = cA + (size_t)(t + 1) * kstep;
            const char* a2 = last ? nA : cA + (size_t)(t + 2) * kstep; const char* b2 = last ? nB : cB + (size_t)(t + 2) * kstep;
            const char* a3 = a2 + kstep; const char* b3 = b2 + kstep;
            if (last && has_next) S.a_ready(nxt);
            if constexpr (SP2) {
            PG8_LDB(B0, 0, 0); PG8_LDB(B1, 0, 1); PG8_SCHED; PG8_LDA(At, 0, 0); PG8_STAGE(PG8_SA(1, 1), a1 + hstep, voffA);
            PG8_WAIT_V(8); PG8_WAIT_L(0); PG8_BAR; PG8_MMA(0, 0, At, B0); PG8_MMA(0, 1, At, B1); PG8_BAR; PG8_SCHED;
            PG8_LDA(At, 0, 1); PG8_STAGE(PG8_SB(0, 0), b2, voffB); PG8_STAGE(PG8_SB(0, 1), b2 + hstep, voffB); PG8_STAGE(PG8_SA(0, 0), a2, voffA);
            PG8_WAIT_V(8); PG8_WAIT_L(0); PG8_BAR; PG8_MMA(1, 0, At, B0); PG8_MMA(1, 1, At, B1); PG8_BAR; PG8_SCHED;
            PG8_LDB(B0, 1, 0); PG8_LDB(B1, 1, 1); PG8_SCHED; PG8_LDA(At, 1, 0); PG8_STAGE(PG8_SA(0, 1), a2 + hstep, voffA);
            PG8_WAIT_V(8); PG8_WAIT_L(0); PG8_BAR; PG8_MMA(0, 0, At, B0); PG8_MMA(0, 1, At, B1); PG8_BAR; PG8_SCHED;
            PG8_LDA(At, 1, 1); PG8_STAGE(PG8_SB(1, 0), b3, voffB); PG8_STAGE(PG8_SB(1, 1), b3 + hstep, voffB); PG8_STAGE(PG8_SA(1, 0), a3, voffA);
            PG8_WAIT_V(8); PG8_WAIT_L(0); PG8_BAR; PG8_MMA(1, 0, At, B0); PG8_MMA(1, 1, At, B1); PG8_BAR; PG8_SCHED;
            } else {
            PG8_LDB(B0, 0, 0); PG8_SCHED; PG8_LDA(At, 0, 0); PG8_STAGE(PG8_SA(1, 1), a1 + hstep, voffA);
            PG8_WAIT_L(8); PG8_BAR; PG8_WAIT_L(0); PG8_MMA(0, 0, At, B0); PG8_BAR; PG8_SCHED;
            PG8_LDB(B1, 0, 1); PG8_STAGE(PG8_SB(0, 0), b2, voffB);
            PG8_BAR; PG8_WAIT_L(0); PG8_MMA(0, 1, At, B1); PG8_BAR;
            PG8_LDA(At, 0, 1); PG8_STAGE(PG8_SA(0, 0), a2, voffA);
            PG8_BAR; PG8_WAIT_L(0); PG8_MMA(1, 0, At, B0); PG8_BAR; PG8_SCHED;
            PG8_STAGE(PG8_SB(0, 1), b2 + hstep, voffB);
            PG8_WAIT_V(6); PG8_BAR; PG8_MMA(1, 1, At, B1); PG8_BAR;
            PG8_LDB(B0, 1, 0); PG8_SCHED; PG8_LDA(At, 1, 0); PG8_STAGE(PG8_SA(0, 1), a2 + hstep, voffA);
            PG8_WAIT_L(8); PG8_BAR; PG8_WAIT_L(0); PG8_MMA(0, 0, At, B0); PG8_BAR; PG8_SCHED;
            PG8_LDB(B1, 1, 1); PG8_STAGE(PG8_SB(1, 0), b3, voffB);
            PG8_BAR; PG8_WAIT_L(0); PG8_MMA(0, 1, At, B1); PG8_BAR;
            PG8_LDA(At, 1, 1); PG8_STAGE(PG8_SA(1, 0), a3, voffA);
            PG8_BAR; PG8_WAIT_L(0); PG8_MMA(1, 0, At, B0); PG8_BAR; PG8_SCHED;
            PG8_STAGE(PG8_SB(1, 1), b3 + hstep, voffB);
            PG8_WAIT_V(6); PG8_BAR; PG8_MMA(1, 1, At, B1); PG8_BAR;
            }
        }
        if constexpr (ALIGN_EPI) { if (wr == 0) PG8_BAR; }
        if constexpr (!Epi::AFTER_DRAIN) { E(acc, cur, wr, wc, fr, fq); S.done(cur); }
        if (!has_next) break;
#pragma unroll
        for (int a = 0; a < 2; ++a)
#pragma unroll
            for (int b = 0; b < 2; ++b)
#pragma unroll
                for (int m = 0; m < 4; ++m)
#pragma unroll
                    for (int n = 0; n < 2; ++n) acc[a][b][m][n] = (f32x4){0.f, 0.f, 0.f, 0.f};
        cur = nxt; cA = nA; cB = nB; ++ui;
        if constexpr (ALIGN_EPI) { if (wr == 1) PG8_BAR; }
    }
    PG8_WAIT_V(0);
    if constexpr (!ALIGN_EPI) { if (wr == 0) PG8_BAR; }
    PG8_BAR;
    if constexpr (Epi::AFTER_DRAIN) { E.fused(acc, cur, wr, wc, fr, fq, lds, wid, lane); S.done(cur); }
#undef PG8_SA
#undef PG8_SB
#undef PG8_STAGE
#undef PG8_LDA
#undef PG8_LDB
#undef PG8_MMA
#undef PG8_WAIT_V
#undef PG8_WAIT_L
#undef PG8_BAR
#undef PG8_SCHED
}
}

#define XB_TMO      128
#define XB_XCNT(j)  (256  + 64 * (j))
#define XB_XSUB(j)  (1280 + 64 * (j))
#define XB_XGEN(j)  (2304 + 64 * (j))
#define XB_TOP      3328
#define XB_TOPGEN   3392
#define XCD_BAR_WORDS 3456
#define XB_SPIN_CAP (1u << 18)
#define LAS __attribute__((address_space(3)))

__device__ __forceinline__ unsigned xb_ld(unsigned* p)              { return __hip_atomic_load(p, __ATOMIC_RELAXED, __HIP_MEMORY_SCOPE_AGENT); }
__device__ __forceinline__ unsigned xb_add(unsigned* p, unsigned v) { return __hip_atomic_fetch_add(p, v, __ATOMIC_RELAXED, __HIP_MEMORY_SCOPE_AGENT); }
__device__ __forceinline__ unsigned xb_xcc_id() { return (unsigned)__builtin_amdgcn_s_getreg((3 << 11) | 20) & 0xFu; }
#define XB_SPIN(cond, bar) do { unsigned _sp = 0; while (cond) { __builtin_amdgcn_s_sleep(1); \
    if ((++_sp & 255u) == 0u) { if (xb_ld(&(bar)[XB_TMO])) break; if (_sp > XB_SPIN_CAP) { atomicAdd(&(bar)[XB_TMO], 1u); break; } } } } while (0)

struct XcdBarrier {
    unsigned* bar; unsigned x;
    volatile LAS unsigned* st;
};

__device__ __forceinline__ XcdBarrier xcd_barrier_post(unsigned* bar, volatile LAS unsigned* st) {
    XcdBarrier b; b.bar = bar; b.x = xb_xcc_id(); b.st = st;
    if (threadIdx.x == 0) (void)xb_add(&bar[XB_XCNT(b.x)], 1u);
    return b;
}
__device__ __forceinline__ void xcd_barrier_complete(unsigned* bar, unsigned x, unsigned& nloc, unsigned& nx) {
    const unsigned G = gridDim.x * gridDim.y * gridDim.z;
    unsigned sum, cnt, mine, sp = 0u;
    for (;;) {
        sum = 0u; cnt = 0u; mine = 0u;
#pragma unroll
        for (unsigned j = 0; j < 16; ++j) { const unsigned c = xb_ld(&bar[XB_XCNT(j)]); sum += c; cnt += (c > 0u) ? 1u : 0u; mine = (j == x) ? c : mine; }
        if (sum == G) break;
        __builtin_amdgcn_s_sleep(1);
        if ((++sp & 255u) == 0u) { if (xb_ld(&bar[XB_TMO])) break; if (sp > XB_SPIN_CAP) { atomicAdd(&bar[XB_TMO], 1u); break; } }
    }
    nloc = mine > 0u ? mine : 1u; nx = cnt > 0u ? cnt : 1u;
}

__device__ __forceinline__ void xcd_barrier(const XcdBarrier& b) {
    asm volatile("s_waitcnt vmcnt(0)" ::: "memory");
    __syncthreads();
    if (threadIdx.x == 0) {
        unsigned* bar = b.bar;
        __builtin_amdgcn_s_waitcnt(0);
        unsigned nloc = b.st[0], nx = b.st[1];
        if (nloc == 0u) { xcd_barrier_complete(bar, b.x, nloc, nx); b.st[0] = nloc; b.st[1] = nx; }
        const unsigned old = xb_add(&bar[XB_XSUB(b.x)], 1u);
        const unsigned gen = old / nloc;
        if (old + 1u == (gen + 1u) * nloc) {
            __builtin_amdgcn_fence(__ATOMIC_RELEASE, "agent");
            asm volatile("s_waitcnt vmcnt(0)" ::: "memory");
            const unsigned og = xb_add(&bar[XB_TOP], 1u);
            const unsigned tg = og / nx;
            if (og + 1u == (tg + 1u) * nx) xb_add(&bar[XB_TOPGEN], 1u);
            else XB_SPIN(xb_ld(&bar[XB_TOPGEN]) == tg, bar);
            __builtin_amdgcn_fence(__ATOMIC_ACQUIRE, "agent");
            xb_add(&bar[XB_XGEN(b.x)], 1u);
            asm volatile("s_waitcnt vmcnt(0)" ::: "memory");
        } else {
            XB_SPIN(xb_ld(&bar[XB_XGEN(b.x)]) == gen, bar);
            __builtin_amdgcn_fence(__ATOMIC_ACQUIRE, "agent");
            asm volatile("s_waitcnt vmcnt(0)" ::: "memory");
        }
    }
    __syncthreads();
}


typedef float f32x4 __attribute__((ext_vector_type(4)));
typedef unsigned u32x4 __attribute__((ext_vector_type(4)));
typedef unsigned u32x2 __attribute__((ext_vector_type(2)));
typedef short bf16x8 __attribute__((ext_vector_type(8)));
typedef unsigned short bf16_t;
namespace {
constexpr int D_MODEL = 1024, BATCH = 8, SEQ = 2048, DEC_B = 32, DEC_T = 8, PAST = 16384, PAGE = 128, NPAGES = 128;
constexpr int NPROMPT = BATCH * SEQ, NSAMP = DEC_B * DEC_T, NTOK = NPROMPT + NSAMP;
constexpr int D_IN = 3352, NV = 3584;
constexpr int C_U = 0, C_V = 512, C_ZA = 1024, C_Q = 1536, C_KC = 2048, C_VC = 2176, C_KS = 2304, C_VS = 2432, C_KW = 2560, C_VW = 2688, C_G = 2816, C_ZB = 2840;
constexpr float EPS = 1e-6f, SCALE = 0.125f, NEGF = -1e30f, FORCEF = 1e9f;
constexpr size_t O_YP = 0, O_YS = 16777216, O_KVP = 17039360, O_WINP = 25427968, O_KVS = 26476544, O_WINS = 26607616, O_VS = 30801920;
constexpr int LDS_BYTES = 147456, MISC_OFF = 131072;
constexpr int NTHREADS = 512, NWAVES = 8;

struct Params {
    const float *x_prompt, *x_sample, *cache, *state_win; const int* page_table;
    const float *norm_g, *w_in, *ln_g, *ln_b, *w_s, *b_s, *cmp_pos, *w_cmp1, *b_cmp1, *w_cmp2, *w_out, *final_g;
    float* out;
    unsigned* ctl;
    bf16_t *XN, *WinT, *WoutT, *W1T, *W2T, *WSB, *U, *GV, *SZA, *Q, *QR, *KC, *VC, *KS, *VS, *KW, *VW, *SZB, *MRG;
    bf16_t *CKP, *CVTP, *CKS, *CVTS, *VSTT, *VWTT, *DUM;
    float *VST, *SG, *ROPE, *CBP;
    float *P, *QR1, *mrg, *ypre, *hidp, *hids, *ckp, *cks;
    int lo, hi, li, pad;
};

__device__ __forceinline__ float bf2f(bf16_t v) { return __uint_as_float((unsigned)v << 16); }
__device__ __forceinline__ unsigned pk2(float lo, float hi) { return pg8::cvt_pk_bf16(lo, hi); }
__device__ __forceinline__ float fast_exp(float x) { return __builtin_amdgcn_exp2f(x * 1.4426950408889634f); }
__device__ __forceinline__ float fast_sigmoid(float x) { return __builtin_amdgcn_rcpf(1.0f + fast_exp(-x)); }
__device__ __forceinline__ float gelu_fast(float x) { const float u = 1.5957691216057308f * (x + 0.044715f * x * x * x); return x * fast_sigmoid(u); }
__device__ __forceinline__ float silu_fast(float x) { return x * fast_sigmoid(x); }
__device__ __forceinline__ float wave_sum(float v) {
#pragma unroll
    for (int o = 1; o < 64; o <<= 1) v += __shfl_xor(v, o);
    return v; }
__device__ __forceinline__ float wave_max(float v) {
#pragma unroll
    for (int o = 1; o < 64; o <<= 1) v = fmaxf(v, __shfl_xor(v, o));
    return v; }
__device__ __forceinline__ const float* xrow(const Params& p, int r) { return r < NPROMPT ? p.x_prompt + (size_t)r * D_MODEL : p.x_sample + (size_t)(r - NPROMPT) * D_MODEL; }

__device__ __forceinline__ int vgroup_actual(int vg) {
    const int tile = vg >> 3, gi = vg & 7, bj = gi >> 2, wc = gi & 3;
    if (tile < 2) return C_U + tile * 256 + gi * 32;
    if (tile < 4) return C_V + (tile - 2) * 256 + gi * 32;
    if (tile < 6) return C_ZA + (tile - 4) * 256 + gi * 32;
    if (tile < 8) return C_Q + (tile - 6) * 256 + wc * 64 + bj * 32;
    if (tile == 8) return C_KC + gi * 32;
    if (tile == 9) return (wc < 2 ? C_KS + wc * 64 : C_KW + (wc - 2) * 64) + bj * 32;
    if (tile == 10) return gi < 4 ? C_VS + gi * 32 : C_VW + (gi - 4) * 32;
    if (tile < 13) return C_ZB + (tile - 11) * 256 + gi * 32;
    return gi == 0 ? C_G : -1;
}

template <bool PERMK = false> __device__ __forceinline__ void tr_item(const float* src, int ld_src, bf16_t* dst, int ld_dst, LAS float* scr, int lane) {
    if (src) {
#pragma unroll 8
        for (int i = 0; i < 32; ++i) { const int kk = 2 * i + (lane >> 5); scr[kk * 33 + (lane & 31)] = src[(size_t)kk * ld_src + (lane & 31)]; }
    }
    asm volatile("s_waitcnt lgkmcnt(0)" ::: "memory");
    const int c = lane & 7;
#pragma unroll
    for (int j = 0; j < 4; ++j) { const int n = (lane >> 3) + 8 * j; const LAS float* s = scr + (8 * c) * 33 + n;
        u32x4 o = (u32x4){0u, 0u, 0u, 0u};
        if (src && PERMK) {
            const LAS float* t = scr + (32 * (c >> 2) + 4 * (c & 3)) * 33 + n;
            o.x = pk2(t[0 * 33], t[1 * 33]); o.y = pk2(t[2 * 33], t[3 * 33]); o.z = pk2(t[16 * 33], t[17 * 33]); o.w = pk2(t[18 * 33], t[19 * 33]); }
        else if (src) { o.x = pk2(s[0 * 33], s[1 * 33]); o.y = pk2(s[2 * 33], s[3 * 33]); o.z = pk2(s[4 * 33], s[5 * 33]); o.w = pk2(s[6 * 33], s[7 * 33]); }
        *(u32x4*)(dst + (size_t)n * ld_dst + 8 * c) = o; }
    asm volatile("s_waitcnt lgkmcnt(0)" ::: "memory");
}
__device__ __forceinline__ void rms_row_to_bf16(const float* xr_, const float* g, bf16_t* orow, int lane) {
    const f32x4* xr = (const f32x4*)xr_ + lane; const f32x4* gr = (const f32x4*)g + lane;
    f32x4 v[4]; float s = 0.f;
#pragma unroll
    for (int j = 0; j < 4; ++j) { v[j] = xr[64 * j]; s += (v[j].x * v[j].x + v[j].y * v[j].y) + (v[j].z * v[j].z + v[j].w * v[j].w); }
    const float rs = 1.0f / sqrtf(wave_sum(s) * (1.0f / D_MODEL) + EPS);
    unsigned long long* o8 = (unsigned long long*)orow + lane;
#pragma unroll
    for (int j = 0; j < 4; ++j) { const f32x4 gg = gr[64 * j];
        o8[64 * j] = (unsigned long long)pk2(v[j].x * rs * gg.x, v[j].y * rs * gg.y) | ((unsigned long long)pk2(v[j].z * rs * gg.z, v[j].w * rs * gg.w) << 32); }
}
__device__ __forceinline__ void p0_prologue(const Params& p, LAS unsigned char* lds) {
    const int tid = threadIdx.x, lane = tid & 63, wave = __builtin_amdgcn_readfirstlane(tid >> 6);
    const int G = gridDim.x, gw = blockIdx.x * NWAVES + wave, NGW = G * NWAVES, gt = blockIdx.x * NTHREADS + tid, NGT = G * NTHREADS;
    LAS float* scr = (LAS float*)(lds + wave * 16384);
    constexpr int I_IN = 16 * 112, I_OUT = 16 * 32, I_W1 = 2 * 32 * 4, I_W2 = 2 * 2 * 2, I_ALL = I_IN + I_OUT + I_W1 + I_W2;
    for (int it = gw; it < I_ALL; it += NGW) {
        int r = it;
        if (r < I_IN) { const int kb = r / 112, vg = r % 112, ac = vgroup_actual(vg);
            tr_item(ac >= 0 ? p.w_in + (size_t)(64 * kb) * D_IN + ac : nullptr, D_IN, p.WinT + (size_t)(32 * vg) * D_MODEL + 64 * kb, D_MODEL, scr, lane); continue; }
        r -= I_IN;
        if (r < I_OUT) { const int kb = r / 32, ng = r % 32; tr_item(p.w_out + (size_t)(64 * kb) * D_MODEL + 32 * ng, D_MODEL, p.WoutT + (size_t)(32 * ng) * D_MODEL + 64 * kb, D_MODEL, scr, lane); continue; }
        r -= I_OUT;
        if (r < I_W1) { const int kv = r / 128, kb = (r % 128) / 4, ng = r % 4;
            tr_item<true>(p.w_cmp1 + ((size_t)kv * 2048 + 64 * kb) * 128 + 32 * ng, 128, p.W1T + ((size_t)kv * 128 + 32 * ng) * 2048 + 64 * kb, 2048, scr, lane); continue; }
        r -= I_W1;
        { const int kv = r / 4, kb = (r % 4) / 2, ng = r % 2;
            tr_item(p.w_cmp2 + ((size_t)kv * 128 + 64 * kb) * 64 + 32 * ng, 64, p.W2T + ((size_t)kv * 64 + 32 * ng) * 128 + 64 * kb, 128, scr, lane); }
    }
    for (int m = gw; m < NTOK; m += NGW) rms_row_to_bf16(xrow(p, m), p.norm_g, p.XN + (size_t)m * D_MODEL, lane);
    for (int idx = gt; idx < 2056 * 32; idx += NGT) {
        const int pi = idx >> 5, i = idx & 31; const double pos = pi < 2048 ? (double)pi : (double)(PAST + pi - 2048);
        double inv = 1.0; for (int k = 0; k < i; ++k) inv *= 0.7498942093324559;
        const double a = pos * inv, k = rint(a * 0.15915494309189535), r = fma(-k, 2.4492935982947064e-16, fma(-k, 6.283185307179586, a)), r2 = r * r;
        double sn = 1.0, cs = 1.0;
#pragma unroll
        for (int n = 13; n >= 1; --n) { sn = 1.0 - sn * r2 / (double)((2 * n) * (2 * n + 1)); cs = 1.0 - cs * r2 / (double)((2 * n - 1) * (2 * n)); }
        p.ROPE[2 * idx] = (float)cs; p.ROPE[2 * idx + 1] = (float)(sn * r);
    }
    for (int idx = gt; idx < DEC_B * 504 * 64; idx += NGT) { const int b = idx / (504 * 64), o4 = idx % (504 * 64);
        ((f32x4*)(p.out + O_WINS + (size_t)b * 512 * 256))[o4] = ((const f32x4*)(p.state_win + (size_t)b * 512 * 256 + 8 * 256))[o4]; }
    for (int idx = gt; idx < 8 * 128 * 128; idx += NGT) { const int t = (idx >> 7) & 127, s = idx & 127; p.WSB[idx] = s <= t ? (bf16_t)(pk2(p.w_s[idx], 0.f) & 0xffffu) : (bf16_t)0; }
    if (blockIdx.x < 32) {
        const int kv = blockIdx.x >> 4, part = blockIdx.x & 15, hid = tid & 127, sub = tid >> 7;
        float s = 0.f; const int x0 = part * 128 + sub * 32;
        for (int x = x0; x < x0 + 32; ++x) s += p.cmp_pos[kv * 2048 + x] * p.w_cmp1[((size_t)kv * 2048 + x) * 128 + hid];
        __syncthreads();
        LAS float* rd = (LAS float*)lds; rd[tid] = s; __syncthreads();
        if (tid < 128) p.CBP[(kv * 16 + part) * 128 + tid] = (rd[tid] + rd[128 + tid]) + (rd[256 + tid] + rd[384 + tid]);
        __syncthreads();
    }
}

struct EpiInProj {
    static constexpr bool PERM = true, AFTER_DRAIN = false;
    const Params& p;
    __device__ __forceinline__ static void st8(bf16_t* dst, const float (&v)[8]) { u32x4 w; w.x = pk2(v[0], v[1]); w.y = pk2(v[2], v[3]); w.z = pk2(v[4], v[5]); w.w = pk2(v[6], v[7]); *(u32x4*)dst = w; }
    __device__ __forceinline__ static void st8f(float* dst, const float (&v)[8]) { *(f32x4*)dst = (f32x4){v[0], v[1], v[2], v[3]}; *(f32x4*)(dst + 4) = (f32x4){v[4], v[5], v[6], v[7]}; }
    __device__ __forceinline__ static void get8(const f32x4 (&a)[2], float (&v)[8]) { v[0] = a[0][0]; v[1] = a[0][1]; v[2] = a[0][2]; v[3] = a[0][3]; v[4] = a[1][0]; v[5] = a[1][1]; v[6] = a[1][2]; v[7] = a[1][3]; }
    __device__ __forceinline__ void operator()(const f32x4 (&acc)[2][2][4][2], const pg8::Unit& u, int wr, int wc, int fr, int fq) const {
        const int tile = u.pn, c8 = 8 * fq;
#pragma unroll
        for (int ai = 0; ai < 2; ++ai)
#pragma unroll
            for (int m = 0; m < 4; ++m) {
                const int row = u.pm * 256 + ai * 128 + wr * 64 + m * 16 + fr;
                const bool samp = row >= NPROMPT; const int sr = row - NPROMPT;
                const int b = samp ? sr >> 3 : row >> 11, t = samp ? sr & 7 : row & 2047, pi = samp ? 2048 + t : t;
                float* outrow = samp ? p.out + O_KVS + (size_t)sr * 512 : p.out + O_KVP + (size_t)row * 512;
                float* winrow = samp ? p.out + O_WINS + ((size_t)b * 512 + 504 + t) * 256 : (t >= SEQ - 512 ? p.out + O_WINP + ((size_t)b * 512 + t - (SEQ - 512)) * 256 : nullptr);
                float v0[8], v1[8]; get8(acc[ai][0][m], v0); get8(acc[ai][1][m], v1);
                if (tile < 6 || tile == 11 || tile == 12) {
                    bf16_t* dst; int cb; bool is_gelu = tile < 4;
                    if (tile < 2) { dst = p.U; cb = tile * 256; } else if (tile < 4) { dst = p.GV; cb = (tile - 2) * 256; } else if (tile < 6) { dst = p.SZA; cb = (tile - 4) * 256; } else { dst = p.SZB; cb = (tile - 11) * 256; }
#pragma unroll
                    for (int e = 0; e < 8; ++e) { v0[e] = is_gelu ? gelu_fast(v0[e]) : silu_fast(v0[e]); v1[e] = is_gelu ? gelu_fast(v1[e]) : silu_fast(v1[e]); }
                    bf16_t* d = dst + (size_t)row * 512 + cb + 32 * wc + c8;
                    u32x4 w0, w1; w0.x = pk2(v0[0], v0[1]); w0.y = pk2(v0[2], v0[3]); w0.z = pk2(v0[4], v0[5]); w0.w = pk2(v0[6], v0[7]);
                    w1.x = pk2(v1[0], v1[1]); w1.y = pk2(v1[2], v1[3]); w1.z = pk2(v1[4], v1[5]); w1.w = pk2(v1[6], v1[7]);
                    *(u32x4*)d = w0; *(u32x4*)(d + 128) = w1;
                    if (tile == 2 || tile == 3) {
                        float s = 0.f, q = 0.f;
#pragma unroll
                        for (int k = 0; k < 4; ++k) { const unsigned a = w0[k], c = w1[k];
                            const float a0 = __uint_as_float(a << 16), a1 = __uint_as_float(a & 0xffff0000u), c0 = __uint_as_float(c << 16), c1 = __uint_as_float(c & 0xffff0000u);
                            s += (a0 + a1) + (c0 + c1); q += (a0 * a0 + a1 * a1) + (c0 * c0 + c1 * c1); }
                        s += __shfl_xor(s, 16); s += __shfl_xor(s, 32); q += __shfl_xor(q, 16); q += __shfl_xor(q, 32);
                        if (fq == 0) { float* st = p.VST + ((size_t)row * 8 + (tile - 2) * 4 + wc) * 2; st[0] = s; st[1] = q; }
                    }
                } else if (tile == 6 || tile == 7 || tile == 9) {
                    const float* rp = p.ROPE + ((size_t)pi * 32 + c8) * 2; float cs[16];
#pragma unroll
                    for (int k = 0; k < 4; ++k) { const f32x4 t4 = *(const f32x4*)(rp + 4 * k); cs[4 * k] = t4[0]; cs[4 * k + 1] = t4[1]; cs[4 * k + 2] = t4[2]; cs[4 * k + 3] = t4[3]; }
                    float r0[8], r1[8];
#pragma unroll
                    for (int e = 0; e < 8; ++e) { const float c = cs[2 * e], s = cs[2 * e + 1]; r0[e] = v0[e] * c - v1[e] * s; r1[e] = v1[e] * c + v0[e] * s; }
                    if (tile != 9) {
                        const int hh = (tile - 6) * 4 + wc; const size_t o = (size_t)row * 512 + hh * 64 + c8;
#pragma unroll
                        for (int e = 0; e < 8; ++e) { v0[e] *= SCALE; v1[e] *= SCALE; r0[e] *= SCALE; r1[e] *= SCALE; }
                        st8(p.Q + o, v0); st8(p.Q + o + 32, v1); st8(p.QR + o, r0); st8(p.QR + o + 32, r1);
                    } else if (wc < 2) {
                        const int h = wc; st8f(outrow + 256 + h * 64 + c8, r0); st8f(outrow + 256 + h * 64 + 32 + c8, r1);
                        st8(p.KS + (size_t)row * 128 + h * 64 + c8, r0); st8(p.KS + (size_t)row * 128 + h * 64 + 32 + c8, r1);
                    } else {
                        const int h = wc - 2; st8(p.KW + (size_t)row * 128 + h * 64 + c8, r0); st8(p.KW + (size_t)row * 128 + h * 64 + 32 + c8, r1);
                        if (winrow) { st8f(winrow + h * 64 + c8, r0); st8f(winrow + h * 64 + 32 + c8, r1); }
                    }
                } else if (tile == 8) {
                    st8f(outrow + 32 * wc + c8, v0); st8f(outrow + 128 + 32 * wc + c8, v1);
                    st8(p.KC + (size_t)row * 128 + 32 * wc + c8, v0); st8(p.VC + (size_t)row * 128 + 32 * wc + c8, v1);
                } else if (tile == 10) {
                    st8f(outrow + 384 + 32 * wc + c8, v0); st8(p.VS + (size_t)row * 128 + 32 * wc + c8, v0);
                    st8(p.VW + (size_t)row * 128 + 32 * wc + c8, v1); if (winrow) st8f(winrow + 128 + 32 * wc + c8, v1);
                    if (!samp) { const size_t to = ((size_t)(b * 2 + (wc >> 1)) * 64 + 32 * (wc & 1) + c8) * SEQ + t;
#pragma unroll
                        for (int e = 0; e < 8; ++e) { p.VSTT[to + (size_t)e * SEQ] = (bf16_t)(pk2(v0[e], 0.f) & 0xffffu); p.VWTT[to + (size_t)e * SEQ] = (bf16_t)(pk2(v1[e], 0.f) & 0xffffu); } }
                } else {
                    if (wc == 0 && fq < 3) {
#pragma unroll
                        for (int e = 0; e < 8; ++e) v0[e] = fast_sigmoid(v0[e]);
                        st8f(p.SG + (size_t)row * 24 + c8, v0);
                    }
                }
            }
    }
};

__device__ __forceinline__ void gmlp_unit(const Params& p, LAS unsigned char* lds, int unit) {
    int tid_ = threadIdx.x; asm volatile("" : "+v"(tid_));
    const int tid = tid_, lane = tid & 63, wave = tid >> 6, c = lane & 15, q = lane >> 4;
    const int ch = unit >> 3, g = unit & 7, r0 = ch * 128;
    LAS float* stat = (LAS float*)(lds + 32768); LAS bf16_t* VT = (LAS bf16_t*)lds;
    __syncthreads();
    if (tid < 128) { const float* st = p.VST + (size_t)(r0 + tid) * 16; float s = 0.f, qq = 0.f;
#pragma unroll
        for (int k = 0; k < 8; ++k) { s += st[2 * k]; qq += st[2 * k + 1]; }
        const float mu = s * (1.0f / 512.0f), var = fmaxf(qq * (1.0f / 512.0f) - mu * mu, 0.f); stat[2 * tid] = mu; stat[2 * tid + 1] = 1.0f / sqrtf(var + EPS); }
    __syncthreads();
    { const int tok = tid >> 2, cs = (tid & 3) * 16; const bf16_t* src = p.GV + (size_t)(r0 + tok) * 512 + g * 64 + cs;
      const u32x4 a = *(const u32x4*)src, b = *(const u32x4*)(src + 8); const float mu = stat[2 * tok], rs = stat[2 * tok + 1];
      const float* lg = p.ln_g + g * 64 + cs; const float* lb = p.ln_b + g * 64 + cs;
#pragma unroll
      for (int e = 0; e < 16; ++e) { const unsigned w = e < 8 ? a[e >> 1] : b[(e - 8) >> 1]; const float v = (e & 1) ? __uint_as_float(w & 0xffff0000u) : __uint_as_float(w << 16);
          const float vn = (v - mu) * rs * lg[e] + lb[e]; VT[(cs + e) * 136 + tok] = (bf16_t)(pk2(vn, 0.f) & 0xffffu); } }
    __syncthreads();
    f32x4 acc[4];
#pragma unroll
    for (int i = 0; i < 4; ++i) acc[i] = (f32x4){0.f, 0.f, 0.f, 0.f};
    const int nks = (wave >> 1) + 1; const bf16_t* wrow = p.WSB + ((size_t)g * 128 + wave * 16 + c) * 128 + 8 * q;
    for (int ks = 0; ks < nks; ++ks) {
        const bf16x8 wf = *(const bf16x8*)(wrow + 32 * ks);
#pragma unroll
        for (int dt = 0; dt < 4; ++dt) { const bf16x8 vf = *(const LAS bf16x8*)(VT + (dt * 16 + c) * 136 + 32 * ks + 8 * q);
            acc[dt] = __builtin_amdgcn_mfma_f32_16x16x32_bf16(vf, wf, acc[dt], 0, 0, 0); }
    }
    const int t = wave * 16 + c; const float bs = p.b_s[g * 128 + t]; const size_t ro = (size_t)(r0 + t) * 512 + g * 64, mo = (size_t)(r0 + t) * 1024 + g * 64;
#pragma unroll
    for (int dt = 0; dt < 4; ++dt) { const int d = dt * 16 + 4 * q; const u32x2 uu = *(const u32x2*)(p.U + ro + d), zz = *(const u32x2*)(p.SZA + ro + d);
        const float o0 = (acc[dt][0] + bs) * __uint_as_float(uu.x << 16) * __uint_as_float(zz.x << 16), o1 = (acc[dt][1] + bs) * __uint_as_float(uu.x & 0xffff0000u) * __uint_as_float(zz.x & 0xffff0000u);
        const float o2 = (acc[dt][2] + bs) * __uint_as_float(uu.y << 16) * __uint_as_float(zz.y << 16), o3 = (acc[dt][3] + bs) * __uint_as_float(uu.y & 0xffff0000u) * __uint_as_float(zz.y & 0xffff0000u);
        u32x2 w; w.x = pk2(o0, o1); w.y = pk2(o2, o3); *(u32x2*)(p.MRG + mo + d) = w; }
}
__device__ __forceinline__ void gmlp_sample_unit(const Params& p, int b) {
    int tid_ = threadIdx.x; asm volatile("" : "+v"(tid_));
    const int c = tid_, g = c >> 6; float vn[8];
#pragma unroll
    for (int t = 0; t < 8; ++t) { const int r = NPROMPT + b * 8 + t; const float* st = p.VST + (size_t)r * 16; float s = 0.f, qq = 0.f;
#pragma unroll
        for (int k = 0; k < 8; ++k) { s += st[2 * k]; qq += st[2 * k + 1]; }
        const float mu = s * (1.0f / 512.0f), var = fmaxf(qq * (1.0f / 512.0f) - mu * mu, 0.f), rs = 1.0f / sqrtf(var + EPS);
        vn[t] = (bf2f(p.GV[(size_t)r * 512 + c]) - mu) * rs * p.ln_g[c] + p.ln_b[c]; p.out[O_VS + (size_t)(b * 8 + t) * 512 + c] = vn[t]; }
#pragma unroll
    for (int t = 0; t < 8; ++t) { const int r = NPROMPT + b * 8 + t; const float* w = p.w_s + ((size_t)g * 128 + t) * 128; float m = p.b_s[g * 128 + t];
#pragma unroll
        for (int s = 0; s < 8; ++s) if (s <= t) m += w[s] * vn[s];
        p.MRG[(size_t)r * 1024 + c] = (bf16_t)(pk2(bf2f(p.U[(size_t)r * 512 + c]) * m * bf2f(p.SZA[(size_t)r * 512 + c]), 0.f) & 0xffffu); }
}
template <bool SAMPLE, bool DUMMY = false, int DMODE = 0> __device__ __forceinline__ void compress_unit(const Params& p, LAS unsigned char* lds, int unit) {
    constexpr int BROW = 128, NSUB = SAMPLE ? 4 : 1;
    int tid_ = threadIdx.x; asm volatile("" : "+v"(tid_));
    const int tid = tid_, lane = tid & 63, wave = __builtin_amdgcn_readfirstlane(tid >> 6), c = lane & 15, q = lane >> 4;
    int b, kv, h, half = 0;
    if (SAMPLE) { half = unit & 1; h = (unit >> 1) & 1; kv = (unit >> 2) & 1; b = unit >> 3; } else { h = unit & 1; kv = (unit >> 1) & 1; b = unit >> 2; }
    LAS unsigned char* Bb = lds; LAS float* XB = (LAS float*)(lds + 73728); LAS float* NXT = XB + 8 * 128; LAS float* RED = NXT + 128; LAS float* CB = RED + 1024;
    __syncthreads();
    if (tid < 128) { float s = p.b_cmp1[kv * 128 + tid];
#pragma unroll
        for (int k = 0; k < 16; ++k) s += p.CBP[(kv * 16 + k) * 128 + tid];
        CB[tid] = s; }
    if (SAMPLE && half == 0) {
        const int tok0 = 16 * 512; const int phys = p.page_table[b * NPAGES + (tok0 >> 7)];
        const float* sb = p.cache + ((((size_t)phys * PAGE + (tok0 & 127)) * 4 + kv) * 2 + h) * 64 + 4 * q;
        const bf16_t* wb = p.W1T + ((size_t)kv * 128 + c) * 2048 + 1024 + 8 * q;
        f32x4 ax[8];
#pragma unroll
        for (int nt = 0; nt < 8; ++nt) ax[nt] = (f32x4){0.f, 0.f, 0.f, 0.f};
#pragma unroll
        for (int ksl = 0; ksl < 4; ++ksl) { const int ks = wave * 4 + ksl, T = ks >> 1, e = ks & 1;
            const f32x4 a0 = *(const f32x4*)(sb + T * 512 + 32 * e), a1 = *(const f32x4*)(sb + T * 512 + 32 * e + 16);
            u32x4 w; w.x = pk2(a0.x, a0.y); w.y = pk2(a0.z, a0.w); w.z = pk2(a1.x, a1.y); w.w = pk2(a1.z, a1.w); const bf16x8 af = __builtin_bit_cast(bf16x8, w);
#pragma unroll
            for (int nt = 0; nt < 8; ++nt) { const bf16x8 wf = *(const bf16x8*)(wb + (size_t)(16 * nt) * 2048 + 32 * ks); ax[nt] = __builtin_amdgcn_mfma_f32_16x16x32_bf16(wf, af, ax[nt], 0, 0, 0); } }
        if (c == 0) {
#pragma unroll
            for (int nt = 0; nt < 8; ++nt)
#pragma unroll
                for (int r = 0; r < 4; ++r) RED[wave * 128 + 16 * nt + 4 * q + r] = ax[nt][r]; }
        __syncthreads();
        if (tid < 128) { float s8 = 0.f;
#pragma unroll
            for (int w8 = 0; w8 < 8; ++w8) s8 += RED[w8 * 128 + tid];
            NXT[tid] = s8; }
    }
    const int n0 = tid >> 3, wpart = tid & 7; const bf16_t* wsrc0 = p.W1T + ((size_t)kv * 128 + n0) * 2048 + wpart * 8; const int wdst0 = n0 * BROW + ((wpart ^ ((n0 >> 1) & 7)) * 16);
#define WSRC(j) (wsrc0 + ((j) & 1) * (64 * 2048) + ((j) >> 1) * 1024)
#define WDST(j) (wdst0 + (j) * (64 * BROW))
    f32x4 ring[2][4]; u32x2 hring[2][4]; u32x4 wring[2][4];
    const float* fb = nullptr; const bf16_t* hb = nullptr;
#define SEGBASE(sub_) do { const int sq_ = (SAMPLE ? 512 * half + 128 * (sub_) : 0) + 16 * wave + c, tok0_ = 16 * sq_; \
        if (SAMPLE) fb = p.cache + ((((size_t)p.page_table[b * NPAGES + (DUMMY ? 0 : (tok0_ >> 7))] * PAGE + (DUMMY ? c : (tok0_ & 127))) * 4 + kv) * 2 + h) * 64 + 4 * q; \
        else hb = (kv ? p.VC : p.KC) + (size_t)(b * SEQ + tok0_) * 128 + h * 64 + 4 * q; } while (0)
#define LOADTOK(slot_, T_) do { _Pragma("unroll") for (int i_ = 0; i_ < 4; ++i_) { \
        if (SAMPLE) ring[slot_][i_] = *(const f32x4*)(fb + (T_) * 512 + 16 * i_); else hring[slot_][i_] = *(const u32x2*)(hb + (T_) * 128 + 16 * i_); } } while (0)
#define LOADW(slot_, S_) do { _Pragma("unroll") for (int j_ = 0; j_ < 4; ++j_) wring[slot_][j_] = *(const u32x4*)(WSRC(j_) + 64 * (S_)); } while (0)
#define STOREW(slot_, bufi_) do { LAS unsigned char* nb_ = Bb + (bufi_) * (256 * BROW); _Pragma("unroll") for (int j_ = 0; j_ < 4; ++j_) *(LAS u32x4*)(nb_ + WDST(j_)) = wring[slot_][j_]; } while (0)
    SEGBASE(NSUB - 1);
    LOADW(0, 0); LOADTOK(0, 0); LOADW(1, 1); LOADTOK(1, 1);
    __syncthreads();
    STOREW(0, 0); LOADW(0, 2);
    __syncthreads();
#pragma unroll 1
    for (int sub = NSUB - 1; sub >= 0; --sub) {
        f32x4 acc[16];
#pragma unroll
        for (int nt = 0; nt < 16; ++nt) acc[nt] = (f32x4){0.f, 0.f, 0.f, 0.f};
#pragma unroll 1
        for (int T4 = 0; T4 < (DMODE == 1 ? 0 : 16); T4 += 4) {
#pragma unroll
            for (int tt = 0; tt < 4; ++tt) { const int T = T4 + tt;
                bf16x8 af[2];
#pragma unroll
                for (int e = 0; e < 2; ++e) { u32x4 w;
                    if (SAMPLE) { const f32x4 a = ring[tt & 1][2 * e], d = ring[tt & 1][2 * e + 1]; w.x = pk2(a.x, a.y); w.y = pk2(a.z, a.w); w.z = pk2(d.x, d.y); w.w = pk2(d.z, d.w); }
                    else { w.x = hring[tt & 1][2 * e].x; w.y = hring[tt & 1][2 * e].y; w.z = hring[tt & 1][2 * e + 1].x; w.w = hring[tt & 1][2 * e + 1].y; }
                    af[e] = __builtin_bit_cast(bf16x8, w); }
                if (T + 2 < 16) LOADTOK(tt & 1, T + 2);
                else if (sub > 0) { if (T == 14) SEGBASE(sub - 1); LOADTOK(tt & 1, T + 2 - 16); }
                const LAS unsigned char* buf = Bb + (T & 1) * (256 * BROW) + c * BROW;
                const int sw = (c >> 1) & 7;
                bf16x8 wr[8];
#define LDW1(i_) wr[(i_) & 7] = *(const LAS bf16x8*)(buf + (16 * ((i_) & 15)) * BROW + (((4 * ((i_) >> 4) + q) ^ sw) * 16))
#define MMW1(i_) acc[(i_) & 15] = __builtin_amdgcn_mfma_f32_16x16x32_bf16(wr[(i_) & 7], af[(i_) >> 4], acc[(i_) & 15], 0, 0, 0)
                __builtin_amdgcn_sched_barrier(0);
#pragma unroll
                for (int i = 0; i < 8; ++i) LDW1(i);
                __builtin_amdgcn_sched_barrier(0);
#pragma unroll
                for (int i = 0; i < 32; ++i) { MMW1(i); if (i + 8 < 32) LDW1(i + 8); __builtin_amdgcn_sched_barrier(0); }
#undef LDW1
#undef MMW1
                if (T < 15 || sub > 0) { STOREW((tt + 1) & 1, (T + 1) & 1); if (T + 3 < 16 || sub > 0) LOADW((tt + 1) & 1, (T + 3) & 15); }
                __syncthreads();
            }
        }
        if (DMODE == 2) { __syncthreads(); continue; }
        int lane_e = lane; asm volatile("" : "+v"(lane_e)); const int c = lane_e & 15, q = lane_e >> 4;
        if (c == 0) {
#pragma unroll
            for (int nt = 0; nt < 8; ++nt)
#pragma unroll
                for (int r = 0; r < 4; ++r) XB[wave * 128 + 16 * nt + 4 * q + r] = acc[8 + nt][r]; }
        __syncthreads();
        const LAS float* nxt = (wave < 7) ? XB + (wave + 1) * 128 : NXT;
        f32x4 o2[4];
#pragma unroll
        for (int dt = 0; dt < 4; ++dt) o2[dt] = (f32x4){0.f, 0.f, 0.f, 0.f};
#pragma unroll
        for (int k2 = 0; k2 < 4; ++k2) {
            float hv[8];
#pragma unroll
            for (int j = 0; j < 8; ++j) { const int nt = 2 * k2 + (j >> 2), r = j & 3, hid = 16 * nt + 4 * q + r;
                float sh = __shfl(acc[8 + nt][r], (lane_e + 1) & 63); if (c == 15) sh = nxt[hid];
                hv[j] = gelu_fast(acc[nt][r] + sh + CB[hid]); }
            u32x4 hw; hw.x = pk2(hv[0], hv[1]); hw.y = pk2(hv[2], hv[3]); hw.z = pk2(hv[4], hv[5]); hw.w = pk2(hv[6], hv[7]); const bf16x8 hf = __builtin_bit_cast(bf16x8, hw);
#pragma unroll
            for (int dt = 0; dt < 4; ++dt) { const bf16_t* w2 = p.W2T + ((size_t)kv * 64 + 16 * dt + c) * 128 + 32 * k2 + 4 * q;
                const u32x2 lo = *(const u32x2*)w2, hi = *(const u32x2*)(w2 + 16); u32x4 w; w.x = lo.x; w.y = lo.y; w.z = hi.x; w.w = hi.y;
                o2[dt] = __builtin_amdgcn_mfma_f32_16x16x32_bf16(__builtin_bit_cast(bf16x8, w), hf, o2[dt], 0, 0, 0); }
        }
        constexpr int NK = SAMPLE ? 1024 : 128, NC = SAMPLE ? 1023 : 127; const int seq = b * 2 + h;
        { const int i = (SAMPLE ? 512 * half + 128 * sub : 0) + 16 * wave + c; if (i < NC) {
#pragma unroll
            for (int dt = 0; dt < 4; ++dt) { const int d = 16 * dt + 4 * q;
                if (kv == 0) { u32x2 w; w.x = pk2(o2[dt][0], o2[dt][1]); w.y = pk2(o2[dt][2], o2[dt][3]); *(u32x2*)((DUMMY ? p.DUM : (SAMPLE ? p.CKS : p.CKP)) + ((size_t)seq * NK + i) * 64 + d) = w; }
                else { bf16_t* vt = (DUMMY ? p.DUM : (SAMPLE ? p.CVTS : p.CVTP)) + ((size_t)seq * 64 + d) * NK + i;
#pragma unroll
                    for (int r = 0; r < 4; ++r) vt[(size_t)r * NK] = (bf16_t)(pk2(o2[dt][r], 0.f) & 0xffffu); } } } }
        __syncthreads();
        if (tid < 128) NXT[tid] = XB[tid];
    }
#undef WSRC
#undef WDST
#undef SEGBASE
#undef LOADTOK
#undef LOADW
#undef STOREW
}
__device__ __forceinline__ void p2_phase(const Params& p, LAS unsigned char* lds) {
    for (int u = blockIdx.x; u < 1344; u += gridDim.x) {
        if (u < 256) compress_unit<true>(p, lds, u);
        else if (u < 288) compress_unit<false>(p, lds, u - 256);
        else if (u < 1312) gmlp_unit(p, lds, u - 288);
        else gmlp_sample_unit(p, u - 1312);
    }
}

typedef float f32x16 __attribute__((ext_vector_type(16)));
constexpr float LOG2E = 1.4426950408889634f;
constexpr int AT_KB = 0, AT_VB = 18432, AT_IMPW = 36864, AT_SC = 69632, AT_SELM = 77824, AT_UNION = 78080;
__device__ __forceinline__ int s_rowidx(int reg, int hf) { return (reg & 3) + 8 * (reg >> 2) + 4 * hf; }
struct KVSrc { const bf16_t* k; const bf16_t* v; int kstride, vstride; };
__device__ __forceinline__ void kv_load(const KVSrc& s, int key0, int tid, u32x4& kr, u32x4& vr) {
    const int r = tid >> 3, part = tid & 7;
    kr = *(const u32x4*)(s.k + (size_t)(key0 + r) * s.kstride + part * 8);
    vr = *(const u32x4*)(s.v + (size_t)r * s.vstride + key0 + part * 8);
}
__device__ __forceinline__ void kv_store(LAS unsigned char* lds, int buf, int tid, const u32x4& kr, const u32x4& vr) {
    const int r = tid >> 3, part = tid & 7;
    *(LAS u32x4*)(lds + AT_KB + buf * 9216 + r * 144 + part * 16) = kr;
    LAS u32x2* vd = (LAS u32x2*)(lds + AT_VB + buf * 8704 + r * 136 + part * 16); vd[0] = (u32x2){vr.x, vr.y}; vd[1] = (u32x2){vr.z, vr.w};
}
__device__ __forceinline__ void qk_block(LAS unsigned char* lds, int buf, const bf16x8 (&qf)[4], int lane, f32x16 (&S)[2]) {
    const int kr = lane & 31, hf = lane >> 5;
#pragma unroll
    for (int kt = 0; kt < 2; ++kt) {
        f32x16 a = {0.f, 0.f, 0.f, 0.f, 0.f, 0.f, 0.f, 0.f, 0.f, 0.f, 0.f, 0.f, 0.f, 0.f, 0.f, 0.f};
#pragma unroll
        for (int ks = 0; ks < 4; ++ks) { const bf16x8 kf = *(const LAS bf16x8*)(lds + AT_KB + buf * 9216 + (32 * kt + kr) * 144 + (16 * ks + 8 * hf) * 2);
            a = __builtin_amdgcn_mfma_f32_32x32x16_bf16(kf, qf[ks], a, 0, 0, 0); }
        S[kt] = a;
    }
}
__device__ __forceinline__ void pv_block(LAS unsigned char* lds, int buf, const f32x16 (&P)[2], int lane, f32x16 (&O)[2]) {
    const int dr = lane & 31, hf = lane >> 5;
#pragma unroll
    for (int s = 0; s < 4; ++s) {
        const f32x16& pp = P[s >> 1]; const int r0 = 8 * (s & 1);
        u32x4 pw; pw.x = pk2(pp[r0], pp[r0 + 1]); pw.y = pk2(pp[r0 + 2], pp[r0 + 3]); pw.z = pk2(pp[r0 + 4], pp[r0 + 5]); pw.w = pk2(pp[r0 + 6], pp[r0 + 7]);
        const bf16x8 pf = __builtin_bit_cast(bf16x8, pw);
#pragma unroll
        for (int dt = 0; dt < 2; ++dt) { const LAS unsigned char* vb = lds + AT_VB + buf * 8704 + (32 * dt + dr) * 136 + (16 * s + 4 * hf) * 2;
            const u32x2 lo = *(const LAS u32x2*)vb, hi = *(const LAS u32x2*)(vb + 16); u32x4 vw; vw.x = lo.x; vw.y = lo.y; vw.z = hi.x; vw.w = hi.y;
            O[dt] = __builtin_amdgcn_mfma_f32_32x32x16_bf16(__builtin_bit_cast(bf16x8, vw), pf, O[dt], 0, 0, 0); }
    }
}
template <class V> __device__ __forceinline__ void softmax_block(f32x16 (&S)[2], float& m, float& l, f32x16 (&O)[2], const V& valid) {
    float mx = NEGF;
#pragma unroll
    for (int kt = 0; kt < 2; ++kt)
#pragma unroll
        for (int r = 0; r < 16; ++r) { const float s = valid(kt, r) ? S[kt][r] : NEGF; S[kt][r] = s; mx = fmaxf(mx, s); }
    mx = fmaxf(mx, __shfl_xor(mx, 32));
    const float mn = fmaxf(m, mx), alpha = __builtin_amdgcn_exp2f((m - mn) * LOG2E), mb = mn * LOG2E; float ps = 0.f;
#pragma unroll
    for (int kt = 0; kt < 2; ++kt)
#pragma unroll
        for (int r = 0; r < 16; ++r) { const float pr = valid(kt, r) ? __builtin_amdgcn_exp2f(S[kt][r] * LOG2E - mb) : 0.f; S[kt][r] = pr; ps += pr; }
    ps += __shfl_xor(ps, 32);
    l = l * alpha + ps; m = mn;
#pragma unroll
    for (int dt = 0; dt < 2; ++dt) O[dt] = O[dt] * alpha;
}
__device__ __forceinline__ void attn_prompt_unit(const Params& p, LAS unsigned char* lds, int b, int h, int qt) {
    int tid_ = threadIdx.x; asm volatile("" : "+v"(tid_));
    const int tid = tid_, lane = tid & 63, wave = tid >> 6, g = wave >> 1, qh = wave & 1, hf = lane >> 5;
    const int ql = 32 * qh + (lane & 31), tq = qt * 64 + ql, row = b * SEQ + tq, hh = h * 4 + g, seq = b * 2 + h;
    LAS float* IMPW = (LAS float*)(lds + AT_IMPW); LAS float* SC = (LAS float*)(lds + AT_SC); LAS unsigned* SELM = (LAS unsigned*)(lds + AT_SELM); LAS unsigned* UNI = (LAS unsigned*)(lds + AT_UNION);
    __syncthreads();
    if (tid < 64) SELM[tid] = 0u; if (tid == 64) UNI[0] = 0u;
    bf16x8 qf[4];
#pragma unroll
    for (int ks = 0; ks < 4; ++ks) qf[ks] = *(const bf16x8*)(p.Q + (size_t)row * 512 + hh * 64 + 16 * ks + 8 * hf);
    { const KVSrc cs{p.CKP + (size_t)seq * 128 * 64, p.CVTP + (size_t)seq * 64 * 128, 64, 128}; u32x4 k0, v0, k1, v1; kv_load(cs, 0, tid, k0, v0); kv_load(cs, 64, tid, k1, v1);
      kv_store(lds, 0, tid, k0, v0); kv_store(lds, 1, tid, k1, v1); }
    __syncthreads();
    f32x16 out[2];
    {
        f32x16 S0[2], S1[2]; qk_block(lds, 0, qf, lane, S0); qk_block(lds, 1, qf, lane, S1);
        float mx = NEGF;
#pragma unroll
        for (int kt = 0; kt < 2; ++kt)
#pragma unroll
            for (int r = 0; r < 16; ++r) { const int i0 = 32 * kt + s_rowidx(r, hf), i1 = 64 + i0;
                const float a = (16 * i0 + 31 <= tq) ? S0[kt][r] : NEGF, c = (16 * i1 + 31 <= tq) ? S1[kt][r] : NEGF; S0[kt][r] = a; S1[kt][r] = c; mx = fmaxf(mx, fmaxf(a, c)); }
        mx = fmaxf(mx, __shfl_xor(mx, 32)); const float mb = mx * LOG2E; float ps = 0.f;
#pragma unroll
        for (int kt = 0; kt < 2; ++kt)
#pragma unroll
            for (int r = 0; r < 16; ++r) { const int i0 = 32 * kt + s_rowidx(r, hf), i1 = 64 + i0;
                const float a = (16 * i0 + 31 <= tq) ? __builtin_amdgcn_exp2f(S0[kt][r] * LOG2E - mb) : 0.f, c = (16 * i1 + 31 <= tq) ? __builtin_amdgcn_exp2f(S1[kt][r] * LOG2E - mb) : 0.f;
                S0[kt][r] = a; S1[kt][r] = c; ps += a + c; }
        ps += __shfl_xor(ps, 32); const float inv = 1.0f / fmaxf(ps, 1.0f);
#pragma unroll
        for (int kt = 0; kt < 2; ++kt) { S0[kt] = S0[kt] * inv; S1[kt] = S1[kt] * inv; }
        float prevx = 0.f;
#pragma unroll
        for (int tile = 0; tile < 4; ++tile) { const f32x16& T = (tile < 2) ? S0[tile & 1] : S1[tile & 1];
#pragma unroll
            for (int rq = 0; rq < 4; ++rq) { const float gs = (T[4 * rq] + T[4 * rq + 1]) + (T[4 * rq + 2] + T[4 * rq + 3]); const float x = __shfl_xor(T[4 * rq + 3], 32);
                const int J = 8 * tile + 2 * rq + hf; IMPW[(g * 64 + ql) * 32 + J] = gs + (hf ? x : prevx); prevx = x; } }
        out[0] = (f32x16){0.f, 0.f, 0.f, 0.f, 0.f, 0.f, 0.f, 0.f, 0.f, 0.f, 0.f, 0.f, 0.f, 0.f, 0.f, 0.f}; out[1] = out[0];
        pv_block(lds, 0, S0, lane, out); pv_block(lds, 1, S1, lane, out);
        const float g0 = p.SG[(size_t)row * 24 + hh * 3];
        out[0] = out[0] * g0; out[1] = out[1] * g0;
    }
    __syncthreads();
    {
        const int q = tid >> 3, sub = tid & 7;
        if (qt < 16) { if (sub == 0) SELM[q] = 0xffffffffu; if (tid == 0) UNI[0] = 0xffffffffu; }
        else {
#pragma unroll
            for (int e = 0; e < 4; ++e) { const int j = sub * 4 + e; const float im = (IMPW[(0 * 64 + q) * 32 + j] + IMPW[(1 * 64 + q) * 32 + j]) + (IMPW[(2 * 64 + q) * 32 + j] + IMPW[(3 * 64 + q) * 32 + j]);
                SC[q * 32 + j] = (j == 0 || j == qt || j == qt - 1) ? FORCEF : (j <= qt ? im : NEGF); }
        }
    }
    __syncthreads();
    if (qt >= 16) {
        const int q = tid >> 3, sub = tid & 7; unsigned bits = 0u;
#pragma unroll
        for (int e = 0; e < 4; ++e) { const int j = sub * 4 + e; const float sj = SC[q * 32 + j]; int rank = 0;
            for (int k = 0; k < 32; ++k) { const float sk = SC[q * 32 + k]; rank += (sk > sj || (sk == sj && k < j)) ? 1 : 0; }
            if (rank < 16) bits |= 1u << j; }
        atomicOr((unsigned*)(SELM + q), bits); atomicOr((unsigned*)UNI, bits);
    }
    __syncthreads();
    const unsigned selm = SELM[ql]; const unsigned uni = (unsigned)__builtin_amdgcn_readfirstlane((int)UNI[0]);
#pragma unroll
    for (int ks = 0; ks < 4; ++ks) qf[ks] = *(const bf16x8*)(p.QR + (size_t)row * 512 + hh * 64 + 16 * ks + 8 * hf);
    const float g1 = p.SG[(size_t)row * 24 + hh * 3 + 1], g2 = p.SG[(size_t)row * 24 + hh * 3 + 2];
#pragma unroll 1
    for (int br = 0; br < 2; ++br) {
        const KVSrc src = br == 0 ? KVSrc{p.KS + (size_t)b * SEQ * 128 + h * 64, p.VSTT + (size_t)seq * 64 * SEQ, 128, SEQ} : KVSrc{p.KW + (size_t)b * SEQ * 128 + h * 64, p.VWTT + (size_t)seq * 64 * SEQ, 128, SEQ};
        const int jlo = qt >= 8 ? qt - 8 : 0;
        unsigned blk = br == 0 ? (uni & (qt == 31 ? 0xffffffffu : ((2u << qt) - 1u))) : ((qt == 31 ? 0xffffffffu : ((2u << qt) - 1u)) & ~((1u << jlo) - 1u));
        f32x16 O[2]; O[0] = (f32x16){0.f, 0.f, 0.f, 0.f, 0.f, 0.f, 0.f, 0.f, 0.f, 0.f, 0.f, 0.f, 0.f, 0.f, 0.f, 0.f}; O[1] = O[0]; float m = NEGF, l = 0.f;
        int cur = 0; u32x4 kr, vr;
        { const int j0 = __builtin_ctz(blk); kv_load(src, 64 * j0, tid, kr, vr); kv_store(lds, 0, tid, kr, vr); }
        __syncthreads();
        while (blk) {
            const int j = __builtin_ctz(blk); blk &= blk - 1u;
            if (blk) kv_load(src, 64 * __builtin_ctz(blk), tid, kr, vr);
            f32x16 S[2]; qk_block(lds, cur, qf, lane, S);
            if (br == 0) {
                const bool lsel = (selm >> j) & 1u;
                if (j == qt) softmax_block(S, m, l, O, [&](int kt, int r) { return lsel && (32 * kt + s_rowidx(r, hf) <= ql); });
                else softmax_block(S, m, l, O, [&](int, int) { return lsel; });
            } else {
                if (j == qt) softmax_block(S, m, l, O, [&](int kt, int r) { return 32 * kt + s_rowidx(r, hf) <= ql; });
                else if (j == qt - 8) softmax_block(S, m, l, O, [&](int kt, int r) { return 32 * kt + s_rowidx(r, hf) > ql; });
                else softmax_block(S, m, l, O, [&](int, int) { return true; });
            }
            pv_block(lds, cur, S, lane, O);
            if (blk) kv_store(lds, cur ^ 1, tid, kr, vr);
            __syncthreads(); cur ^= 1;
        }
        const float sc = (br == 0 ? g1 : g2) / fmaxf(l, 1.0f);
        out[0] = out[0] + O[0] * sc; out[1] = out[1] + O[1] * sc;
    }
    const size_t ob = (size_t)row * 512 + hh * 64, mb2 = (size_t)row * 1024 + 512 + hh * 64;
#pragma unroll
    for (int dt = 0; dt < 2; ++dt)
#pragma unroll
        for (int rq = 0; rq < 4; ++rq) { const int d = 32 * dt + 8 * rq + 4 * hf; const u32x2 z = *(const u32x2*)(p.SZB + ob + d);
            u32x2 w; w.x = pk2(out[dt][4 * rq] * __uint_as_float(z.x << 16), out[dt][4 * rq + 1] * __uint_as_float(z.x & 0xffff0000u));
            w.y = pk2(out[dt][4 * rq + 2] * __uint_as_float(z.y << 16), out[dt][4 * rq + 3] * __uint_as_float(z.y & 0xffff0000u)); *(u32x2*)(p.MRG + mb2 + d) = w; }
}
__device__ __forceinline__ void p3_prompt(const Params& p, LAS unsigned char* lds) {
    for (int c = blockIdx.x; c < 256; c += gridDim.x) {
        const int vcu = (c & 7) * 32 + (c >> 3), bh = vcu >> 4, x = vcu & 15;
        attn_prompt_unit(p, lds, bh >> 1, bh & 1, 31 - x);
        attn_prompt_unit(p, lds, bh >> 1, bh & 1, x);
    }
}

struct SoftS { float m, l, o; };
__device__ __forceinline__ void tile_step_s(SoftS& st, const LAS float* Kt, const LAS float* Vt, const LAS float* q, LAS float* ps, bool valid, int lane) {
    float s = 0.f;
#pragma unroll 16
    for (int d = 0; d < 64; ++d) s += q[d] * Kt[lane * 65 + d];
    s = valid ? s : NEGF;
    const float mn = fmaxf(st.m, wave_max(s)), sc = __expf(st.m - mn), pr = valid ? __expf(s - mn) : 0.f;
    st.l = st.l * sc + wave_sum(pr); st.m = mn; ps[lane] = pr;
    __syncthreads();
    float o = st.o * sc;
#pragma unroll 16
    for (int k = 0; k < 64; ++k) o += ps[k] * Vt[k * 64 + lane];
    st.o = o;
    __syncthreads();
}
__device__ __forceinline__ void attn_sample_pair(const Params& p, LAS unsigned char* lds, int pairi) {
    int tid_ = threadIdx.x; asm volatile("" : "+v"(tid_));
    const int half = tid_ >> 8, tid = tid_ & 255, lane = tid & 63, g = tid >> 6, bid = pairi * 2 + half;
    const int t = bid & 7, h = (bid >> 3) & 1, b = bid >> 4, r = NPROMPT + b * DEC_T + t, tq = PAST + t, seq = b * 2 + h, hh = h * 4 + g;
    LAS unsigned char* L = lds + half * 57344;
    LAS float* sc = (LAS float*)L; LAS float* Kt = sc + 4 * 1024; LAS float* Vt = Kt + 64 * 65; LAS float* qs = Vt + 64 * 64; LAS float* qrs = qs + 256; LAS float* ps = qrs + 256; LAS float* score = ps + 256; LAS int* sel = (LAS int*)(score + 264);
    __syncthreads();
    qs[g * 64 + lane] = bf2f(p.Q[(size_t)r * 512 + hh * 64 + lane]); qrs[g * 64 + lane] = bf2f(p.QR[(size_t)r * 512 + hh * 64 + lane]);
    __syncthreads();
    const bf16_t* CK = p.CKS + (size_t)seq * 1024 * 64; const bf16_t* CVT = p.CVTS + (size_t)seq * 64 * 1024;
    float mx = NEGF;
    for (int i = lane; i < 1023; i += 64) { float s = 0.f; const u32x4* k4 = (const u32x4*)(CK + (size_t)i * 64);
#pragma unroll
        for (int c = 0; c < 8; ++c) { const u32x4 w = k4[c];
#pragma unroll
            for (int e = 0; e < 4; ++e) s += qs[g * 64 + c * 8 + 2 * e] * __uint_as_float(w[e] << 16) + qs[g * 64 + c * 8 + 2 * e + 1] * __uint_as_float(w[e] & 0xffff0000u); }
        s = (16 * i + 31 <= tq) ? s : NEGF; sc[g * 1024 + i] = s; mx = fmaxf(mx, s); }
    mx = wave_max(mx); float sum = 0.f;
    for (int i = lane; i < 1023; i += 64) { const float e = (16 * i + 31 <= tq) ? __expf(sc[g * 1024 + i] - mx) : 0.f; sc[g * 1024 + i] = e; sum += e; }
    sum = wave_sum(sum); const float inv = 1.0f / fmaxf(sum, 1.0f);
    for (int i = lane; i < 1024; i += 64) sc[g * 1024 + i] = i < 1023 ? sc[g * 1024 + i] * inv : 0.f;
    __syncthreads();
    float ocmp = 0.f;
    for (int i = 0; i < 1024; i += 8) { const u32x4 w = *(const u32x4*)(CVT + (size_t)lane * 1024 + i); const LAS float* pp = sc + g * 1024 + i;
#pragma unroll
        for (int e = 0; e < 4; ++e) ocmp += pp[2 * e] * __uint_as_float(w[e] << 16) + pp[2 * e + 1] * __uint_as_float(w[e] & 0xffff0000u); }
    const int tb = tq >> 6;
    for (int j = tid; j < 257; j += 256) { float im = 0.f; const int lo = max(0, 4 * j - 1), hi = min(1022, 4 * j + 3);
        for (int i = lo; i <= hi; ++i) im += (sc[i] + sc[1024 + i]) + (sc[2048 + i] + sc[3072 + i]);
        const bool forced = (j == 0) || (j == tb) || (j == tb - 1), valid = j * 64 <= tq; score[j] = forced ? FORCEF : (valid ? im : NEGF); }
    __syncthreads();
    for (int j = tid; j < 257; j += 256) { const float sj = score[j]; int rank = 0; for (int k = 0; k < 257; ++k) { const float sk = score[k]; rank += (sk > sj || (sk == sj && k < j)) ? 1 : 0; }
        if (rank < 16) sel[rank] = j; }
    __syncthreads();
    SoftS ss{NEGF, 0.f, 0.f}, sw{NEGF, 0.f, 0.f};
    f32x4 kreg[4], vreg[4];
#define TILE_LOAD(s_) do { const bool is_sel_ = (s_) < 16; const int blk_ = is_sel_ ? sel[(s_)] : (s_) - 16, lim_ = is_sel_ ? PAST : 512; \
        _Pragma("unroll") for (int it_ = 0; it_ < 4; ++it_) { const int idx_ = tid + 256 * it_, k_ = idx_ >> 4, d4_ = (idx_ & 15) * 4, pos_ = blk_ * 64 + k_; \
            if (pos_ < lim_) { const float* kp_ = is_sel_ ? p.cache + ((((size_t)p.page_table[b * NPAGES + (pos_ >> 7)] * PAGE + (pos_ & 127)) * 4 + 2) * 2 + h) * 64 : p.state_win + ((((size_t)b * 512 + pos_) * 2 + 0) * 2 + h) * 64; \
                kreg[it_] = *(const f32x4*)(kp_ + d4_); vreg[it_] = *(const f32x4*)(kp_ + 128 + d4_); } \
            else { const int ni_ = min(pos_ - lim_, DEC_T - 1); const size_t o_ = (size_t)(NPROMPT + b * DEC_T + ni_) * 128 + h * 64 + d4_; const bf16_t* kb_ = is_sel_ ? p.KS : p.KW; const bf16_t* vb_ = is_sel_ ? p.VS : p.VW; \
                const u32x2 a_ = *(const u32x2*)(kb_ + o_), c_ = *(const u32x2*)(vb_ + o_); \
                kreg[it_] = (f32x4){__uint_as_float(a_.x << 16), __uint_as_float(a_.x & 0xffff0000u), __uint_as_float(a_.y << 16), __uint_as_float(a_.y & 0xffff0000u)}; \
                vreg[it_] = (f32x4){__uint_as_float(c_.x << 16), __uint_as_float(c_.x & 0xffff0000u), __uint_as_float(c_.y << 16), __uint_as_float(c_.y & 0xffff0000u)}; } } } while (0)
    TILE_LOAD(0);
#pragma unroll 1
    for (int s = 0; s < 25; ++s) {
        const bool is_sel = s < 16; const int blk = is_sel ? sel[s] : s - 16;
#pragma unroll
        for (int it = 0; it < 4; ++it) { const int idx = tid + 256 * it, k = idx >> 4, d4 = (idx & 15) * 4;
            Kt[k * 65 + d4] = kreg[it].x; Kt[k * 65 + d4 + 1] = kreg[it].y; Kt[k * 65 + d4 + 2] = kreg[it].z; Kt[k * 65 + d4 + 3] = kreg[it].w; *(LAS f32x4*)(Vt + k * 64 + d4) = vreg[it]; }
        __syncthreads();
        if (s < 24) TILE_LOAD(s + 1);
        const int pos = blk * 64 + lane; bool valid;
        if (is_sel) valid = pos <= tq; else { const int kpos = PAST - 512 + pos, dist = tq - kpos; valid = pos < 520 && dist >= 0 && dist < 512; }
        if (is_sel) tile_step_s(ss, Kt, Vt, qrs + g * 64, ps + g * 64, valid, lane); else tile_step_s(sw, Kt, Vt, qrs + g * 64, ps + g * 64, valid, lane);
    }
#undef TILE_LOAD
    const float oslc = ss.o / fmaxf(ss.l, 1.0f), owin = sw.o / fmaxf(sw.l, 1.0f);
    const float g0 = p.SG[(size_t)r * 24 + hh * 3], g1 = p.SG[(size_t)r * 24 + hh * 3 + 1], g2 = p.SG[(size_t)r * 24 + hh * 3 + 2];
    p.MRG[(size_t)r * 1024 + 512 + hh * 64 + lane] = (bf16_t)(pk2((g0 * ocmp + g1 * oslc + g2 * owin) * bf2f(p.SZB[(size_t)r * 512 + hh * 64 + lane]), 0.f) & 0xffffu);
}
__device__ __forceinline__ void p3_phase(const Params& p, LAS unsigned char* lds) {
    for (int u = blockIdx.x; u < 256; u += gridDim.x) attn_sample_pair(p, lds, u);
    p3_prompt(p, lds);
}

struct EpiMerge {
    static constexpr bool PERM = true, AFTER_DRAIN = false;
    const Params& p;
    __device__ __forceinline__ void operator()(const f32x4 (&acc)[2][2][4][2], const pg8::Unit& u, int wr, int wc, int fr, int fq) const {
#pragma unroll
        for (int ai = 0; ai < 2; ++ai)
#pragma unroll
            for (int m = 0; m < 4; ++m) {
                const int row = u.pm * 256 + ai * 128 + wr * 64 + m * 16 + fr; const float* xr = xrow(p, row); float* yr = p.ypre + (size_t)row * D_MODEL;
#pragma unroll
                for (int bj = 0; bj < 2; ++bj) { const int col = u.pn * 256 + bj * 128 + 32 * wc + 8 * fq;
                    const f32x4 x0 = *(const f32x4*)(xr + col), x1 = *(const f32x4*)(xr + col + 4);
                    *(f32x4*)(yr + col) = x0 + acc[ai][bj][m][0]; *(f32x4*)(yr + col + 4) = x1 + acc[ai][bj][m][1]; }
                asm volatile("" ::: "memory");
            }
    }
};
__device__ __forceinline__ void p5_final(const Params& p) {
    const int lane = threadIdx.x & 63, wave = threadIdx.x >> 6, gw = blockIdx.x * NWAVES + wave, NGW = gridDim.x * NWAVES;
    for (int m = gw; m < NTOK; m += NGW) {
        const f32x4* xr = (const f32x4*)(p.ypre + (size_t)m * D_MODEL) + lane; const f32x4* gr = (const f32x4*)p.final_g + lane; f32x4* o = (f32x4*)(p.out + (size_t)m * D_MODEL) + lane;
        f32x4 v[4]; float s = 0.f;
#pragma unroll
        for (int j = 0; j < 4; ++j) { v[j] = xr[64 * j]; s += (v[j].x * v[j].x + v[j].y * v[j].y) + (v[j].z * v[j].z + v[j].w * v[j].w); }
        const float rs = 1.0f / sqrtf(wave_sum(s) * (1.0f / D_MODEL) + EPS);
#pragma unroll
        for (int j = 0; j < 4; ++j) o[64 * j] = v[j] * rs * gr[64 * j];
    }
}

__global__ void __launch_bounds__(NTHREADS, 2) fwd(Params p) {
    extern __shared__ __attribute__((aligned(16))) unsigned char lds_raw[];
    LAS unsigned char* lds = (LAS unsigned char*)lds_raw;
    const int tid = threadIdx.x;
    for (int u = tid; u < (LDS_BYTES - MISC_OFF) / 4; u += NTHREADS) ((LAS unsigned*)(lds + MISC_OFF))[u] = 0u;
    __syncthreads();
    XcdBarrier bar = xcd_barrier_post(p.ctl + 1024 + p.li * XCD_BAR_WORDS, (volatile LAS unsigned*)(lds + MISC_OFF));
    const int lo = p.lo, hi = p.hi;
#define IN(k) (lo <= (k) && (k) < hi)
#define BOTH(k) (IN(k) && IN((k) + 1))
    if (IN(0)) { p0_prologue(p, lds); if (BOTH(0)) xcd_barrier(bar); }
    if (IN(1)) {
        pg8::Gemm g{p.XN, p.WinT, NTOK, NV, D_MODEL}; pg8::StaticOrder S; S.init(NTOK, NV, gridDim.x, (int)blockIdx.x);
        EpiInProj E{p};
        pg8::gemm_phase<EpiInProj, pg8::StaticOrder, true, true>(lds, g, S, E);
        if (BOTH(1)) xcd_barrier(bar);
    }
    if (IN(2)) { p2_phase(p, lds); if (BOTH(2)) xcd_barrier(bar); }
    if (IN(3)) { p3_phase(p, lds); if (BOTH(3)) xcd_barrier(bar); }
    if (IN(4)) {
        pg8::Gemm g{p.MRG, p.WoutT, NTOK, D_MODEL, D_MODEL}; pg8::StaticOrder S; S.init(NTOK, D_MODEL, gridDim.x, (int)blockIdx.x);
        EpiMerge E{p};
        pg8::gemm_phase<EpiMerge, pg8::StaticOrder, true, true>(lds, g, S, E);
        if (BOTH(4)) xcd_barrier(bar);
    }
    if (IN(5)) p5_final(p);
#undef IN
#undef BOTH
}

__global__ __launch_bounds__(256) void k_conv(Params p) {
    const int r = blockIdx.x, t = threadIdx.x; float* P = p.P + (size_t)r * D_IN;
    for (int c = t; c < 512; c += 256) {
        P[C_U + c] = bf2f(p.U[(size_t)r * 512 + c]); P[C_ZA + c] = bf2f(p.SZA[(size_t)r * 512 + c]); P[C_ZB + c] = bf2f(p.SZB[(size_t)r * 512 + c]);
        P[C_Q + c] = bf2f(p.Q[(size_t)r * 512 + c]) * 8.0f; p.QR1[(size_t)r * 512 + c] = bf2f(p.QR[(size_t)r * 512 + c]) * 8.0f;
        float s = 0.f, q = 0.f; for (int k = 0; k < 8; ++k) { s += p.VST[((size_t)r * 8 + k) * 2]; q += p.VST[((size_t)r * 8 + k) * 2 + 1]; }
        const float mu = s * (1.0f / 512.0f), var = q * (1.0f / 512.0f) - mu * mu, rs = 1.0f / sqrtf(var + EPS);
        const float vn = (bf2f(p.GV[(size_t)r * 512 + c]) - mu) * rs * p.ln_g[c] + p.ln_b[c];
        P[C_V + c] = vn;
    }
    if (t < 128) { const size_t o = (size_t)r * 128 + t; P[C_KC + t] = bf2f(p.KC[o]); P[C_VC + t] = bf2f(p.VC[o]); P[C_KS + t] = bf2f(p.KS[o]); P[C_VS + t] = bf2f(p.VS[o]); P[C_KW + t] = bf2f(p.KW[o]); P[C_VW + t] = bf2f(p.VW[o]); }
    if (t < 24) P[C_G + t] = p.SG[(size_t)r * 24 + t];
}

__global__ __launch_bounds__(256) void k_conv3(Params p) {
    const size_t idx = (size_t)blockIdx.x * 256 + threadIdx.x; const int d = idx & 63; size_t rr = idx >> 6;
    if (rr < 2 * 2048) { const int kv = rr / 2048, row = rr % 2048, seq = row / 128, i = row % 128;
        p.ckp[rr * 64 + d] = kv == 0 ? bf2f(p.CKP[((size_t)seq * 128 + i) * 64 + d]) : bf2f(p.CVTP[((size_t)seq * 64 + d) * 128 + i]); return; }
    rr -= 2 * 2048; if (rr >= 2 * 65536) return;
    { const int kv = rr / 65536, row = rr % 65536, seq = row / 1024, i = row % 1024;
        p.cks[rr * 64 + d] = kv == 0 ? bf2f(p.CKS[((size_t)seq * 1024 + i) * 64 + d]) : bf2f(p.CVTS[((size_t)seq * 64 + d) * 1024 + i]); }
}
__global__ __launch_bounds__(256) void k_conv2(Params p) {
    const size_t e = (size_t)blockIdx.x * 256 + threadIdx.x; const size_t row = e >> 7, c4 = (e & 127) * 4; const size_t i = row * 1024 + 512 + c4; const f32x4 v = *(const f32x4*)(p.mrg + i);
    u32x2 w; w.x = pk2(v.x, v.y); w.y = pk2(v.z, v.w); *(u32x2*)(p.MRG + i) = w;
}

__device__ __forceinline__ float gelu_ref(float x) { const float u = 0.7978845608028654f * (x + 0.044715f * x * x * x); return 0.5f * x * (1.0f + tanhf(u)); }
template <class F> __global__ __launch_bounds__(256) void k_gemm(Params p, int M, int N, int K, F f) {
    __shared__ float As[16][132]; __shared__ float Bs[16][132];
    const int tid = threadIdx.x, lane = tid & 63, wid = tid >> 6, wm = wid >> 1, wn = wid & 1, z = blockIdx.z;
    const int m0 = blockIdx.y * 128, n0 = blockIdx.x * 128;
    f32x4 acc[4][4];
    for (int i = 0; i < 4; ++i) for (int j = 0; j < 4; ++j) acc[i][j] = (f32x4){0.f, 0.f, 0.f, 0.f};
    const int ar = tid >> 1, ak = (tid & 1) * 8, bk = tid >> 4, bn = (tid & 15) * 8;
    for (int k0 = 0; k0 < K; k0 += 16) {
        const float4 a0 = f.la(p, z, m0 + ar, k0 + ak), a1 = f.la(p, z, m0 + ar, k0 + ak + 4);
        const float4 b0 = f.lb(p, z, k0 + bk, n0 + bn, N), b1 = f.lb(p, z, k0 + bk, n0 + bn + 4, N);
        As[ak + 0][ar] = a0.x; As[ak + 1][ar] = a0.y; As[ak + 2][ar] = a0.z; As[ak + 3][ar] = a0.w;
        As[ak + 4][ar] = a1.x; As[ak + 5][ar] = a1.y; As[ak + 6][ar] = a1.z; As[ak + 7][ar] = a1.w;
        *(float4*)&Bs[bk][bn] = b0; *(float4*)&Bs[bk][bn + 4] = b1;
        __syncthreads();
#pragma unroll
        for (int ks = 0; ks < 16; ks += 4) {
            float a[4], b[4];
#pragma unroll
            for (int i = 0; i < 4; ++i) { a[i] = As[ks + (lane >> 4)][wm * 64 + i * 16 + (lane & 15)]; b[i] = Bs[ks + (lane >> 4)][wn * 64 + i * 16 + (lane & 15)]; }
#pragma unroll
            for (int i = 0; i < 4; ++i)
#pragma unroll
                for (int j = 0; j < 4; ++j) acc[i][j] = __builtin_amdgcn_mfma_f32_16x16x4f32(a[i], b[j], acc[i][j], 0, 0, 0);
        }
        __syncthreads();
    }
#pragma unroll
    for (int i = 0; i < 4; ++i)
#pragma unroll
      for (int j = 0; j < 4; ++j)
#pragma unroll
        for (int r = 0; r < 4; ++r) {
        const int row = m0 + wm * 64 + i * 16 + (lane >> 4) * 4 + r, col = n0 + wn * 64 + j * 16 + (lane & 15);
        if (row < M && col < N) f.ep(p, z, row, col, acc[i][j][r]);
    }
}
__device__ __forceinline__ float4 ld4(const float* q) { return *(const float4*)q; }
__device__ __forceinline__ float4 zero4() { return make_float4(0.f, 0.f, 0.f, 0.f); }
struct FMerge { int pad;
    __device__ float4 la(const Params& p, int, int r, int k) const { return ld4(p.mrg + (size_t)r * D_MODEL + k); }
    __device__ float4 lb(const Params& p, int, int k, int n, int) const { return ld4(p.w_out + (size_t)k * D_MODEL + n); }
    __device__ void ep(const Params& p, int, int r, int c, float v) const { p.ypre[(size_t)r * D_MODEL + c] = xrow(p, r)[c] + v; }
};
template <bool SAMPLE> struct FCmp { int pad;
    static constexpr int NB = SAMPLE ? 1024 : 128, NC = SAMPLE ? 1023 : 127;
    __device__ float4 la(const Params& p, int kv, int r, int x) const {
        const int seq = r / NB, i = r % NB, b = seq >> 1, h = seq & 1; if (i >= NC) return zero4();
        const int tok = 16 * i + (x >> 6), d = x & 63; float4 v;
        if (SAMPLE) { const int phys = p.page_table[b * NPAGES + (tok >> 7)], off = tok & 127; v = ld4(p.cache + ((((size_t)phys * PAGE + off) * 4 + kv) * 2 + h) * 64 + d); }
        else v = ld4(p.P + (size_t)(b * SEQ + tok) * D_IN + C_KC + kv * 128 + h * 64 + d);
        const float4 pe = ld4(p.cmp_pos + kv * 2048 + x); v.x += pe.x; v.y += pe.y; v.z += pe.z; v.w += pe.w; return v;
    }
    __device__ float4 lb(const Params& p, int kv, int k, int n, int) const { return ld4(p.w_cmp1 + ((size_t)kv * 2048 + k) * 128 + n); }
    __device__ void ep(const Params& p, int kv, int r, int c, float v) const {
        float* hid = SAMPLE ? p.hids : p.hidp; const int M = SAMPLE ? 65536 : 2048;
        hid[((size_t)kv * M + r) * 128 + c] = gelu_ref(v + p.b_cmp1[kv * 128 + c]);
    }
};
__global__ __launch_bounds__(256) void k_cmp2(Params p, int M, int sample) {
    const size_t idx = (size_t)blockIdx.x * 256 + threadIdx.x; const int d = idx & 63; const size_t rr = idx >> 6; if (rr >= (size_t)2 * M) return;
    const int kv = (int)(rr / M); const float* hid = (sample ? p.hids : p.hidp) + rr * 128; const float* w2 = p.w_cmp2 + (size_t)kv * 128 * 64 + d;
    float s = 0.f; for (int k = 0; k < 128; ++k) s += hid[k] * w2[k * 64];
    (sample ? p.cks : p.ckp)[rr * 64 + d] = s;
}
__global__ __launch_bounds__(256) void k_gmlp(Params p) {
    const int ch = blockIdx.x, g = blockIdx.y, tid = threadIdx.x; __shared__ float vn[128][64];
    const int r0 = ch < 128 ? ch * 128 : NPROMPT + (ch - 128) * DEC_T, T = ch < 128 ? 128 : DEC_T;
    for (int idx = tid; idx < T * 64; idx += 256) vn[idx >> 6][idx & 63] = p.P[(size_t)(r0 + (idx >> 6)) * D_IN + C_V + g * 64 + (idx & 63)];
    __syncthreads();
    for (int idx = tid; idx < T * 64; idx += 256) {
        const int t = idx >> 6, d = idx & 63; const float* w = p.w_s + ((size_t)g * 128 + t) * 128; float acc = 0.f;
        for (int s = 0; s <= t; ++s) acc += w[s] * vn[s][d];
        const float mixed = acc + p.b_s[g * 128 + t]; const float* P = p.P + (size_t)(r0 + t) * D_IN;
        p.mrg[(size_t)(r0 + t) * D_MODEL + g * 64 + d] = P[C_U + g * 64 + d] * mixed * P[C_ZA + g * 64 + d];
    }
}
struct Soft { float m, l, o; };
__device__ __forceinline__ void tile_step(Soft& st, const float (*Kt)[65], const float (*Vt)[64], const float* q, float* ps, bool valid, int lane) {
    float s = 0.f;
#pragma unroll 16
    for (int d = 0; d < 64; ++d) s += q[d] * Kt[lane][d];
    s = valid ? s * SCALE : NEGF;
    const float mn = fmaxf(st.m, wave_max(s)), sc = expf(st.m - mn), pr = valid ? expf(s - mn) : 0.f;
    st.l = st.l * sc + wave_sum(pr); st.m = mn; ps[lane] = pr;
    __syncthreads();
    float o = st.o * sc;
#pragma unroll 16
    for (int k = 0; k < 64; ++k) o += ps[k] * Vt[k][lane];
    st.o = o;
    __syncthreads();
}
template <bool SAMPLE> __global__ __launch_bounds__(256) void k_attn(Params p) {
    constexpr int NC = SAMPLE ? 1023 : 127, NCB = SAMPLE ? 1024 : 128, NS = SAMPLE ? 257 : 32, T = SAMPLE ? DEC_T : SEQ;
    __shared__ float sc[4][NCB]; __shared__ float Kt[64][65]; __shared__ float Vt[64][64]; __shared__ float qs[4][64], qrs[4][64], ps[4][64];
    __shared__ float score[NS + 3]; __shared__ int sel[16];
    const int tid = threadIdx.x, lane = tid & 63, g = tid >> 6;
    const int bid = blockIdx.x, t = bid % T, h = (bid / T) & 1, b = bid / (2 * T);
    const int r = SAMPLE ? NPROMPT + b * DEC_T + t : b * SEQ + t, tq = SAMPLE ? PAST + t : t, seq = b * 2 + h, hh = h * 4 + g;
    const float* Pr = p.P + (size_t)r * D_IN;
    qs[g][lane] = Pr[C_Q + hh * 64 + lane]; qrs[g][lane] = p.QR1[(size_t)r * 512 + hh * 64 + lane];
    __syncthreads();
    const float* CK = (SAMPLE ? p.cks : p.ckp) + (size_t)seq * NCB * 64; const float* CV = CK + (size_t)(SAMPLE ? 65536 : 2048) * 64;
    float mx = NEGF;
    for (int i = lane; i < NC; i += 64) { float s = 0.f; const float* k = CK + (size_t)i * 64; for (int d = 0; d < 64; ++d) s += qs[g][d] * k[d];
        s = (16 * i + 31 <= tq) ? s * SCALE : NEGF; sc[g][i] = s; mx = fmaxf(mx, s); }
    mx = wave_max(mx); float sum = 0.f;
    for (int i = lane; i < NC; i += 64) { const float e = (16 * i + 31 <= tq) ? expf(sc[g][i] - mx) : 0.f; sc[g][i] = e; sum += e; }
    sum = wave_sum(sum); const float inv = 1.0f / fmaxf(sum, 1.0f);
    for (int i = lane; i < NC; i += 64) sc[g][i] *= inv;
    __syncthreads();
    float ocmp = 0.f; for (int i = 0; i < NC; ++i) ocmp += sc[g][i] * CV[(size_t)i * 64 + lane];
    __syncthreads();
    const int tb = tq >> 6;
    for (int j = tid; j < NS; j += 256) { float im = 0.f; const int lo = max(0, 4 * j - 1), hi = min(NC - 1, 4 * j + 3);
        for (int i = lo; i <= hi; ++i) im += (sc[0][i] + sc[1][i]) + (sc[2][i] + sc[3][i]);
        const bool forced = (j == 0) || (j == tb) || (j == tb - 1), valid = j * 64 <= tq; score[j] = forced ? FORCEF : (valid ? im : NEGF); }
    __syncthreads();
    for (int j = tid; j < NS; j += 256) { const float sj = score[j]; int rank = 0; for (int k = 0; k < NS; ++k) { const float sk = score[k]; rank += (sk > sj || (sk == sj && k < j)) ? 1 : 0; }
        if (rank < 16) sel[rank] = j; }
    __syncthreads();
    Soft ss{NEGF, 0.f, 0.f};
    for (int s = 0; s < 16; ++s) {
        const int blk = sel[s];
        for (int idx = tid; idx < 64 * 16; idx += 256) { const int k = idx >> 4, d4 = (idx & 15) * 4, pos = blk * 64 + k; const float *kp, *vp;
            if (SAMPLE) { if (pos < PAST) { const int phys = p.page_table[b * NPAGES + (pos >> 7)], off = pos & 127; kp = p.cache + ((((size_t)phys * PAGE + off) * 4 + 2) * 2 + h) * 64; vp = kp + 128; }
                          else { const int ni = min(pos - PAST, DEC_T - 1); kp = p.P + (size_t)(NPROMPT + b * DEC_T + ni) * D_IN + C_KS + h * 64; vp = kp + 128; } }
            else { kp = p.P + (size_t)(b * SEQ + pos) * D_IN + C_KS + h * 64; vp = kp + 128; }
            const float4 kv = ld4(kp + d4), vv = ld4(vp + d4); Kt[k][d4] = kv.x; Kt[k][d4 + 1] = kv.y; Kt[k][d4 + 2] = kv.z; Kt[k][d4 + 3] = kv.w; *(float4*)&Vt[k][d4] = vv; }
        __syncthreads();
        tile_step(ss, Kt, Vt, qrs[g], ps[g], blk * 64 + lane <= tq, lane);
        __syncthreads();
    }
    const float oslc = ss.o / fmaxf(ss.l, 1.0f);
    Soft sw{NEGF, 0.f, 0.f};
    const int c_lo = SAMPLE ? 0 : max(0, tq - 511) >> 6, c_hi = SAMPLE ? 8 : tq >> 6;
    for (int c = c_lo; c <= c_hi; ++c) {
        for (int idx = tid; idx < 64 * 16; idx += 256) { const int k = idx >> 4, d4 = (idx & 15) * 4, pos = c * 64 + k; const float *kp, *vp;
            if (SAMPLE) { if (pos < 512) { kp = p.state_win + ((((size_t)b * 512 + pos) * 2 + 0) * 2 + h) * 64; vp = kp + 128; }
                          else { const int ni = min(pos - 512, DEC_T - 1); kp = p.P + (size_t)(NPROMPT + b * DEC_T + ni) * D_IN + C_KW + h * 64; vp = kp + 128; } }
            else { kp = p.P + (size_t)(b * SEQ + pos) * D_IN + C_KW + h * 64; vp = kp + 128; }
            const float4 kv = ld4(kp + d4), vv = ld4(vp + d4); Kt[k][d4] = kv.x; Kt[k][d4 + 1] = kv.y; Kt[k][d4 + 2] = kv.z; Kt[k][d4 + 3] = kv.w; *(float4*)&Vt[k][d4] = vv; }
        __syncthreads();
        const int idx = c * 64 + lane; bool valid;
        if (SAMPLE) { const int kpos = PAST - 512 + idx, dist = tq - kpos; valid = idx < 520 && dist >= 0 && dist < 512; }
        else { const int dist = tq - idx; valid = dist >= 0 && dist < 512; }
        tile_step(sw, Kt, Vt, qrs[g], ps[g], valid, lane);
        __syncthreads();
    }
    const float owin = sw.o / fmaxf(sw.l, 1.0f);
    const float g0 = Pr[C_G + hh * 3], g1 = Pr[C_G + hh * 3 + 1], g2 = Pr[C_G + hh * 3 + 2];
    p.mrg[(size_t)r * D_MODEL + 512 + hh * 64 + lane] = (g0 * ocmp + g1 * oslc + g2 * owin) * Pr[C_ZB + hh * 64 + lane];
}
__global__ __launch_bounds__(256) void k_final(Params p) {
    const int r = blockIdx.x, t = threadIdx.x; __shared__ float red[4];
    const float4 v = *(const float4*)(p.ypre + (size_t)r * D_MODEL + t * 4);
    float s = wave_sum(v.x * v.x + v.y * v.y + v.z * v.z + v.w * v.w);
    if ((t & 63) == 0) red[t >> 6] = s; __syncthreads();
    s = red[0] + red[1] + red[2] + red[3];
    const float rs = 1.0f / sqrtf(s * (1.0f / D_MODEL) + EPS); const float4 g = *(const float4*)(p.final_g + t * 4);
    float4 o; o.x = v.x * rs * g.x; o.y = v.y * rs * g.y; o.z = v.z * rs * g.z; o.w = v.w * rs * g.w;
    *(float4*)(p.out + (size_t)r * D_MODEL + t * 4) = o;
}
}

extern "C" void kernel_launch(void* const* d_in, const int* in_sizes, int n_in, void* d_out, int out_size, void* d_ws, size_t ws_size, hipStream_t stream) {
    static int grid = 0;
    if (grid == 0) {
        int dev = 0, cus = 0, per_cu = 0;
        hipGetDevice(&dev); hipDeviceGetAttribute(&cus, hipDeviceAttributeMultiprocessorCount, dev);
        if (hipFuncSetAttribute((const void*)fwd, hipFuncAttributeMaxDynamicSharedMemorySize, LDS_BYTES) != hipSuccess) fprintf(stderr, "hipFuncSetAttribute failed\n");
        if (hipOccupancyMaxActiveBlocksPerMultiprocessor(&per_cu, (const void*)fwd, NTHREADS, LDS_BYTES) != hipSuccess || per_cu < 1) fprintf(stderr, "occupancy query: %d\n", per_cu);
        (void)hipGetLastError();
        grid = cus > 0 ? cus : 256;
    }
    Params p{};
    p.x_prompt = (const float*)d_in[0]; p.x_sample = (const float*)d_in[1]; p.cache = (const float*)d_in[2]; p.state_win = (const float*)d_in[3]; p.page_table = (const int*)d_in[4];
    p.norm_g = (const float*)d_in[5]; p.w_in = (const float*)d_in[6]; p.ln_g = (const float*)d_in[7]; p.ln_b = (const float*)d_in[8]; p.w_s = (const float*)d_in[9]; p.b_s = (const float*)d_in[10];
    p.cmp_pos = (const float*)d_in[11]; p.w_cmp1 = (const float*)d_in[12]; p.b_cmp1 = (const float*)d_in[13]; p.w_cmp2 = (const float*)d_in[14]; p.w_out = (const float*)d_in[15]; p.final_g = (const float*)d_in[16];
    p.out = (float*)d_out;
    unsigned char* w = (unsigned char*)d_ws; size_t o = 0;
    auto take = [&](size_t bytes) { unsigned char* r = w + o; o += (bytes + 255) & ~(size_t)255; return r; };
    p.ctl = (unsigned*)take(1 << 20);
    p.XN = (bf16_t*)take((size_t)NTOK * 1024 * 2); p.WinT = (bf16_t*)take((size_t)NV * 1024 * 2); p.WoutT = (bf16_t*)take((size_t)1024 * 1024 * 2);
    p.W1T = (bf16_t*)take((size_t)2 * 128 * 2048 * 2); p.W2T = (bf16_t*)take((size_t)2 * 64 * 128 * 2); p.WSB = (bf16_t*)take((size_t)8 * 128 * 128 * 2);
    p.U = (bf16_t*)take((size_t)NTOK * 512 * 2); p.GV = (bf16_t*)take((size_t)NTOK * 512 * 2); p.SZA = (bf16_t*)take((size_t)NTOK * 512 * 2); p.Q = (bf16_t*)take((size_t)NTOK * 512 * 2);
    p.QR = (bf16_t*)take((size_t)NTOK * 512 * 2); p.SZB = (bf16_t*)take((size_t)NTOK * 512 * 2); p.MRG = (bf16_t*)take((size_t)NTOK * 1024 * 2);
    p.KC = (bf16_t*)take((size_t)NTOK * 128 * 2); p.VC = (bf16_t*)take((size_t)NTOK * 128 * 2); p.KS = (bf16_t*)take((size_t)NTOK * 128 * 2); p.VS = (bf16_t*)take((size_t)NTOK * 128 * 2);
    p.KW = (bf16_t*)take((size_t)NTOK * 128 * 2); p.VW = (bf16_t*)take((size_t)NTOK * 128 * 2);
    p.CKP = (bf16_t*)take((size_t)16 * 128 * 64 * 2); p.CVTP = (bf16_t*)take((size_t)16 * 128 * 64 * 2); p.CKS = (bf16_t*)take((size_t)64 * 1024 * 64 * 2); p.CVTS = (bf16_t*)take((size_t)64 * 1024 * 64 * 2);
    p.DUM = (bf16_t*)take((size_t)64 * 1024 * 64 * 2);
    p.VSTT = (bf16_t*)take((size_t)16 * 64 * SEQ * 2); p.VWTT = (bf16_t*)take((size_t)16 * 64 * SEQ * 2);
    p.VST = (float*)take((size_t)NTOK * 16 * 4); p.SG = (float*)take((size_t)NTOK * 24 * 4); p.ROPE = (float*)take((size_t)2056 * 64 * 4); p.CBP = (float*)take((size_t)2 * 16 * 128 * 4);
    p.P = (float*)take((size_t)NTOK * D_IN * 4); p.QR1 = (float*)take((size_t)NTOK * 512 * 4); p.mrg = (float*)take((size_t)NTOK * 1024 * 4); p.ypre = (float*)take((size_t)NTOK * 1024 * 4);
    p.hidp = (float*)take((size_t)2 * 2048 * 128 * 4); p.hids = (float*)take((size_t)2 * 65536 * 128 * 4); p.ckp = (float*)take((size_t)2 * 2048 * 64 * 4); p.cks = (float*)take((size_t)2 * 65536 * 64 * 4);
    hipMemsetAsync(p.ctl, 0, 1 << 20, stream);
    p.lo = 0; p.hi = 6; p.li = 0; p.pad = 0;
    hipLaunchKernelGGL(fwd, dim3(grid), dim3(NTHREADS), LDS_BYTES, stream, p);
}
```
